# Optimizing an MI355X kernel written in HIP

```python
import jax, jax.numpy as jnp
from jax import lax
import numpy as np

D_MODEL = 1024
BATCH = 2
SEQ = 8192
DEPTH = 4
DEC_BATCH = 128
DEC_SEQ = 1
PAST_LEN = 8192
PAGE_SIZE = 128

N_A = DEPTH // 2
N_B = DEPTH - N_A
N_HEADS = 16
HEAD_DIM = 64
N_KV = 2
GROUP = N_HEADS // N_KV
D_MAIN = N_HEADS * HEAD_DIM
D_RNN = D_MAIN
N_BLOCKS = 16
BLOCK_W = D_RNN // N_BLOCKS
CONV_W = 4
LRU_C = 8.0
WINDOW = 128
ROPE_THETA = 10000.0
N_MEM = 256
MEM_HEADS = 4
MEM_HD = 128
D_MEMW = MEM_HEADS * MEM_HD
D_IN = 2 * D_MAIN + 2 * D_MEMW
D_CAT = D_MAIN + D_MEMW
EPS = 1e-6
NEG = -1e30

kernel_name = "hawk_yoco_swa_sink_memxattn_step"


def rmsnorm(x, g):
    xf = x.astype(jnp.float32)
    y = xf * lax.rsqrt(jnp.mean(xf * xf, axis=-1, keepdims=True) + EPS)
    return (y * g.astype(jnp.float32)).astype(x.dtype)


def rope(x, pos):
    half = HEAD_DIM // 2
    inv = ROPE_THETA ** (-jnp.arange(half, dtype=jnp.float32) / half)
    ang = pos.astype(jnp.float32)[:, None] * inv[None, :]
    cos = jnp.cos(ang)[:, None, :]
    sin = jnp.sin(ang)[:, None, :]
    xf = x.astype(jnp.float32)
    x1, x2 = xf[..., :half], xf[..., half:]
    return jnp.concatenate([x1 * cos - x2 * sin, x2 * cos + x1 * sin], axis=-1).astype(x.dtype)


def causal_conv(u, buf, w, b):
    T = u.shape[1]
    up = jnp.concatenate([buf, u], axis=1)
    y = b + up[:, 0:T] * w[0]
    for k in range(1, CONV_W):
        y = y + up[:, k:k + T] * w[k]
    return y, up[:, T:]


def block_diag(u, w):
    ub = u.reshape(u.shape[:-1] + (N_BLOCKS, BLOCK_W))
    return jnp.einsum('btnc,ncd->btnd', ub, w).reshape(u.shape)


def rglru(u, h0, wa, ba, wx, bx, lam):
    f32 = jnp.float32
    uf = u.astype(f32)
    r = jax.nn.sigmoid(block_diag(uf, wa.astype(f32)) + ba.astype(f32))
    i = jax.nn.sigmoid(block_diag(uf, wx.astype(f32)) + bx.astype(f32))
    log_a = -LRU_C * r * jax.nn.softplus(-lam.astype(f32))
    a = jnp.exp(log_a)
    bterm = jnp.sqrt(-jnp.expm1(2.0 * log_a)) * (i * uf)

    def combine(c1, c2):
        a1, b1 = c1
        a2, b2 = c2
        return a1 * a2, a2 * b1 + b2

    acum, bcum = lax.associative_scan(combine, (a, bterm), axis=1)
    h = acum * h0.astype(f32)[:, None, :] + bcum
    return h.astype(u.dtype), h[:, -1].astype(u.dtype)


def mem_attend(q, mk, mv):
    s = jnp.einsum('bthd,bmhd->bhtm', q, mk, preferred_element_type=jnp.float32) * (MEM_HD ** -0.5)
    p = jax.nn.softmax(s, axis=-1).astype(mv.dtype)
    return jnp.einsum('bhtm,bmhd->bthd', p, mv)


def sink_attend(q, k, v, mask, sink):
    s = jnp.einsum('...qkgd,...skd->...kgqs', q, k, preferred_element_type=jnp.float32) * (HEAD_DIM ** -0.5)
    s = jnp.where(mask, s, NEG)
    sk = sink.astype(jnp.float32).reshape(N_KV, GROUP, 1, 1)
    m = jnp.maximum(jnp.max(s, axis=-1, keepdims=True), sk)
    p = jnp.exp(s - m)
    p = p / (jnp.sum(p, axis=-1, keepdims=True) + jnp.exp(sk - m))
    return jnp.einsum('...kgqs,...skd->...qkgd', p.astype(v.dtype), v)


def band_mask(nb):
    qi = jnp.arange(WINDOW)[:, None] + WINDOW
    ki = jnp.arange(2 * WINDOW)[None, :]
    local = (ki <= qi) & (qi - ki < WINDOW)
    valid = (jnp.arange(nb)[:, None, None] * WINDOW - WINDOW + ki[None]) >= 0
    return local[None] & valid


def shift_blocks(xb):
    return jnp.concatenate([jnp.zeros_like(xb[:, :1]), xb[:, :-1]], axis=1)


def trunk(x, pos, mem_k, mem_v, h0, conv0, win_k0, win_v0, prompt,
          norm_g, w_in, w_out, conv_w, conv_b, lru_wa, lru_ba, lru_wx, lru_bx, lru_lambda,
          kv_norm_g, w_kv, sinks, final_g):
    B, T, _ = x.shape
    new_h, new_conv = [], []
    for l in range(DEPTH):
        hn = rmsnorm(x, norm_g[l])
        proj = hn @ w_in[l]
        u, g_main, q_mem, g_mem = jnp.split(proj, [D_MAIN, 2 * D_MAIN, 2 * D_MAIN + D_MEMW], axis=-1)
        if l < N_A:
            uc, cbuf = causal_conv(u, conv0[l], conv_w[l], conv_b[l])
            y, h_last = rglru(uc, h0[l], lru_wa[l], lru_ba[l], lru_wx[l], lru_bx[l], lru_lambda[l])
            new_h.append(h_last)
            new_conv.append(cbuf)
        else:
            if l == N_A:
                kv = rmsnorm(x, kv_norm_g) @ w_kv
                k_new, v_new = jnp.split(kv, 2, axis=-1)
                k_new = rope(k_new.reshape(B, T, N_KV, HEAD_DIM), pos)
                v_new = v_new.reshape(B, T, N_KV, HEAD_DIM)
                if prompt:
                    nb = T // WINDOW
                    kb = k_new.reshape(B, nb, WINDOW, N_KV, HEAD_DIM)
                    vb = v_new.reshape(B, nb, WINDOW, N_KV, HEAD_DIM)
                    k_att = jnp.concatenate([shift_blocks(kb), kb], axis=2)
                    v_att = jnp.concatenate([shift_blocks(vb), vb], axis=2)
                    mask = band_mask(nb)[:, None, None]
                    win_k, win_v = k_new[:, T - WINDOW:], v_new[:, T - WINDOW:]
                else:
                    k_att = jnp.concatenate([win_k0, k_new], axis=1)
                    v_att = jnp.concatenate([win_v0, v_new], axis=1)
                    kpos = PAST_LEN - WINDOW + jnp.arange(WINDOW + T)
                    mask = (kpos[None, :] <= pos[:, None]) & (pos[:, None] - kpos[None, :] < WINDOW)
                    win_k, win_v = k_att[:, T:], v_att[:, T:]
            q = rope(u.reshape(B, T, N_HEADS, HEAD_DIM), pos)
            if prompt:
                q = q.reshape(B, T // WINDOW, WINDOW, N_KV, GROUP, HEAD_DIM)
            else:
                q = q.reshape(B, T, N_KV, GROUP, HEAD_DIM)
            y = sink_attend(q, k_att, v_att, mask, sinks[l - N_A]).reshape(B, T, D_MAIN)
        om = mem_attend(q_mem.reshape(B, T, MEM_HEADS, MEM_HD), mem_k[l], mem_v[l]).reshape(B, T, D_MEMW)
        z = jnp.concatenate([y * jax.nn.silu(g_main), om * jax.nn.silu(g_mem)], axis=-1)
        x = x + z @ w_out[l]
    return rmsnorm(x, final_g), jnp.stack(new_h), jnp.stack(new_conv), win_k, win_v


def setup_inputs(seed: int = 0) -> dict:
    key = jax.random.key(seed)
    ks = jax.random.split(key, 25)
    nrm = jax.random.normal
    a0 = jax.random.uniform(ks[20], (N_A, D_RNN), minval=0.9, maxval=0.999)
    return {
        'x_prompt': nrm(ks[0], (BATCH, SEQ, D_MODEL), jnp.float32),
        'x_sample': nrm(ks[1], (DEC_BATCH, DEC_SEQ, D_MODEL), jnp.float32),
        'cache_mem_k': nrm(ks[2], (DEPTH, DEC_BATCH, N_MEM, MEM_HEADS, MEM_HD), jnp.float32),
        'cache_mem_v': nrm(ks[3], (DEPTH, DEC_BATCH, N_MEM, MEM_HEADS, MEM_HD), jnp.float32),
        'state_lru_h': 0.5 * nrm(ks[4], (N_A, DEC_BATCH, D_RNN), jnp.float32),
        'state_conv': nrm(ks[5], (N_A, DEC_BATCH, CONV_W - 1, D_RNN), jnp.float32),
        'cache_win_k': nrm(ks[6], (DEC_BATCH, WINDOW, N_KV, HEAD_DIM), jnp.float32),
        'cache_win_v': nrm(ks[7], (DEC_BATCH, WINDOW, N_KV, HEAD_DIM), jnp.float32),
        'mem_prompt': nrm(ks[8], (BATCH, N_MEM, D_MODEL), jnp.float32),
        'norm_g': 1.0 + 0.05 * nrm(ks[9], (DEPTH, D_MODEL), jnp.float32),
        'w_in': nrm(ks[10], (DEPTH, D_MODEL, D_IN), jnp.float32) * D_MODEL ** -0.5,
        'w_out': nrm(ks[11], (DEPTH, D_CAT, D_MODEL), jnp.float32) * D_CAT ** -0.5,
        'mem_norm_g': 1.0 + 0.05 * nrm(ks[12], (DEPTH, D_MODEL), jnp.float32),
        'w_mem_kv': nrm(ks[13], (DEPTH, D_MODEL, 2 * D_MEMW), jnp.float32) * D_MODEL ** -0.5,
        'conv_w': nrm(ks[14], (N_A, CONV_W, D_RNN), jnp.float32) * CONV_W ** -0.5,
        'conv_b': 0.02 * nrm(ks[15], (N_A, D_RNN), jnp.float32),
        'lru_wa': nrm(ks[16], (N_A, N_BLOCKS, BLOCK_W, BLOCK_W), jnp.float32) * BLOCK_W ** -0.5,
        'lru_ba': 0.1 * nrm(ks[17], (N_A, D_RNN), jnp.float32),
        'lru_wx': nrm(ks[18], (N_A, N_BLOCKS, BLOCK_W, BLOCK_W), jnp.float32) * BLOCK_W ** -0.5,
        'lru_bx': 0.1 * nrm(ks[19], (N_A, D_RNN), jnp.float32),
        'lru_lambda': jnp.log(a0) - jnp.log1p(-a0),
        'kv_norm_g': 1.0 + 0.05 * nrm(ks[21], (D_MODEL,), jnp.float32),
        'w_kv': nrm(ks[22], (D_MODEL, 2 * N_KV * HEAD_DIM), jnp.float32) * D_MODEL ** -0.5,
        'sinks': 0.5 * nrm(ks[23], (N_B, N_HEADS), jnp.float32),
        'final_g': 1.0 + 0.05 * nrm(ks[24], (D_MODEL,), jnp.float32),
    }


def reference(x_prompt, x_sample, cache_mem_k, cache_mem_v, state_lru_h, state_conv,
              cache_win_k, cache_win_v, mem_prompt, norm_g, w_in, w_out, mem_norm_g, w_mem_kv,
              conv_w, conv_b, lru_wa, lru_ba, lru_wx, lru_bx, lru_lambda, kv_norm_g, w_kv,
              sinks, final_g):
    weights = (norm_g, w_in, w_out, conv_w, conv_b, lru_wa, lru_ba, lru_wx, lru_bx, lru_lambda,
               kv_norm_g, w_kv, sinks, final_g)
    mem_n = rmsnorm(mem_prompt[None], mem_norm_g[:, None, None, :])
    mkv = jnp.einsum('lbmd,lde->lbme', mem_n, w_mem_kv)
    mk_p, mv_p = jnp.split(mkv, 2, axis=-1)
    mk_p = mk_p.reshape(mk_p.shape[:3] + (MEM_HEADS, MEM_HD))
    mv_p = mv_p.reshape(mv_p.shape[:3] + (MEM_HEADS, MEM_HD))
    bp, tp = x_prompt.shape[0], x_prompt.shape[1]
    h0_p = jnp.zeros((N_A, bp, D_RNN), x_prompt.dtype)
    c0_p = jnp.zeros((N_A, bp, CONV_W - 1, D_RNN), x_prompt.dtype)
    pos_p = jnp.arange(tp, dtype=jnp.int32)
    y_p, h_p, conv_p, wk_p, wv_p = trunk(x_prompt, pos_p, mk_p, mv_p, h0_p, c0_p, None, None, True, *weights)
    pos_s = PAST_LEN + jnp.arange(x_sample.shape[1], dtype=jnp.int32)
    y_s, h_s, conv_s, wk_s, wv_s = trunk(x_sample, pos_s, cache_mem_k, cache_mem_v, state_lru_h, state_conv,
                                         cache_win_k, cache_win_v, False, *weights)
    return (y_p, y_s, mk_p, mv_p, h_p, conv_p, wk_p, wv_p, h_s, conv_s, wk_s, wv_s)
```

```cpp
#include <hip/hip_runtime.h>
#include <cstdio>
#include <cstdint>
constexpr int DM = 1024;
constexpr int SEQ = 8192, NB = 2;
constexpr int MP = NB * SEQ;
constexpr int MS = 128;
constexpr int MV = MP + MS;
constexpr int MPAD = 16640;
constexpr int DEPTH = 4, N_A = 2;
constexpr int DIN = 3072, DCAT = 1536, DMAIN = 1024, DMEMW = 512;
constexpr int NMEM = 256, MEMH = 4, MEMHD = 128;
constexpr int NHEADS = 16, HD = 64, NKV = 2, WIN = 128;
constexpr float EPS = 1e-6f;
constexpr float LOG2E = 1.4426950408889634f;
constexpr float QSCALE = 0.125f * LOG2E;
constexpr float MSCALE = 0.08838834764831845f * LOG2E;
constexpr size_t O_YP = 0, O_YS = 16777216, O_MK = 16908288, O_MV = 17956864, O_HP = 19005440, O_CP = 19009536, O_WKP = 19021824, O_WVP = 19054592,
                 O_HS = 19087360, O_CS = 19349504, O_WKS = 20135936, O_WVS = 22233088, O_END = 24330240;
#define MK_PER_PHASE 0
namespace pg8 {
#define PG8_LAS __attribute__((address_space(3)))
typedef unsigned short bf16_t;
typedef short bf16x8 __attribute__((ext_vector_type(8)));
typedef float f32x4 __attribute__((ext_vector_type(4)));
typedef unsigned u32x4 __attribute__((ext_vector_type(4)));
constexpr int BM = 256, BK = 64, HALF = 128, HTB = HALF * BK * 2  , STAGE_BYTES = 8 * HTB, NXCD = 8, WGM = 8;

__host__ __device__ __forceinline__ int lds_byte(int r, int c) { const int st = (r >> 4) * 2 + (c >> 5), rr = r & 15, cc = c & 31, ob = rr * 64 + cc * 2; return st * 1024 + (ob ^ (((ob >> 9) & 1) << 5)); }
__host__ __device__ __forceinline__ void stage_rc(int b, int& R, int& C) { const int st = b / 1024, sb = b % 1024, swz = sb ^ (((sb >> 9) & 1) << 5); R = (st >> 1) * 16 + swz / 64; C = (st & 1) * 32 + (swz % 64) / 2; }
__host__ __device__ __forceinline__ int perm32(int rho) { const int n = rho >> 4, i = rho & 15; return 8 * (i >> 2) + 4 * n + (i & 3); }

struct Unit { int pm, pn; };
struct Gemm { const bf16_t* A; const bf16_t* Bt; int M, N, K; };

struct StaticOrder {
    int nM, nN, nwg, G, c;
    __host__ __device__ void init(int M, int N, int G_, int c_) { nM = M / BM; nN = N / BM; nwg = nM * nN; G = G_; c = c_; }
    __host__ __device__ bool next(int i, Unit& u) const {
        const long L = (long)i * G + c; if (L >= nwg) return false;
        int wgid = (int)L; { const int q = nwg / NXCD, r = nwg % NXCD, xcd = wgid % NXCD, off = wgid / NXCD; wgid = (xcd < r ? xcd * (q + 1) : r * (q + 1) + (xcd - r) * q) + off; }
        const int nig = WGM * nN, gid = wgid / nig, fm = gid * WGM, gsz = (nM - fm) < WGM ? (nM - fm) : WGM;
        u.pm = fm + ((wgid % nig) % gsz); u.pn = (wgid % nig) / gsz; return true;
    }
    __device__ __forceinline__ void a_ready(const Unit&) const {}
    __device__ __forceinline__ void done(const Unit&) const {}
};
__device__ __forceinline__ unsigned cvt_pk_bf16(float lo, float hi) { unsigned r; asm volatile("v_cvt_pk_bf16_f32 %0, %1, %2" : "=v"(r) : "v"(lo), "v"(hi)); return r; }
typedef float f32x2 __attribute__((ext_vector_type(2)));
typedef unsigned u32x2 __attribute__((ext_vector_type(2)));
__device__ __forceinline__ float silu_f(float g) { return g * __builtin_amdgcn_rcpf(1.0f + __builtin_amdgcn_exp2f(-g * LOG2E)); }
__device__ __forceinline__ u32x4 pack8(const f32x4 a, const f32x4 b) { u32x4 w; w.x = cvt_pk_bf16(a[0], a[1]); w.y = cvt_pk_bf16(a[2], a[3]); w.z = cvt_pk_bf16(b[0], b[1]); w.w = cvt_pk_bf16(b[2], b[3]); return w; }
struct EpiIn {
    static constexpr bool PERM = true, AFTER_DRAIN = false;
    bf16_t* proj; bf16_t* kb; bf16_t* vb; const float* rowsq; const float* rope; float* out; int att;
    __device__ __forceinline__ void operator()(const f32x4 (&acc)[2][2][4][2], const Unit& u, int wr, int wc, int fr, int fq) const {
        const int pn = u.pn;
        const int kind = pn < 4 ? (att ? 1 : 0) : pn < 8 ? 2 : pn < 10 ? 3 : pn < 12 ? 2 : 4;
        const int g = 4 * (wc & 1) + fq;
        const int colb = wc * 32 + 8 * fq;
#pragma unroll
        for (int ai = 0; ai < 2; ++ai)
#pragma unroll
            for (int m = 0; m < 4; ++m) {
                const int r = u.pm * BM + ai * HALF + wr * 64 + m * 16 + fr;
                const float rs = __builtin_amdgcn_rsqf(rowsq[r] * (1.0f / 1024.0f) + EPS);
                f32x4 cs = (f32x4){1.f, 1.f, 1.f, 1.f}, sn = (f32x4){0.f, 0.f, 0.f, 0.f};
                if (kind == 1 || kind == 4) { const int pos = r < MP ? (r & (SEQ - 1)) : SEQ; const float* rp = rope + (size_t)pos * 64 + 4 * g; cs = *(const f32x4*)rp; sn = *(const f32x4*)(rp + 32); }
#pragma unroll
                for (int bj = 0; bj < 2; ++bj) {
                    f32x4 v0 = acc[ai][bj][m][0] * rs, v1 = acc[ai][bj][m][1] * rs;
                    if (kind == 4) {
                        if (bj == 0) {
                            const f32x4 o0 = v0 * cs - v1 * sn, o1 = v1 * cs + v0 * sn;
                            *(u32x4*)(kb + (size_t)r * 128 + colb) = pack8(o0, o1);
                            const int kvh = wc >> 1;
                            float* dst = nullptr;
                            if (r < MP) { const int t = r & (SEQ - 1); if (t >= SEQ - WIN) dst = out + O_WKP + ((size_t)((r >> 13) * WIN + (t - (SEQ - WIN))) * 2 + kvh) * 64; }
                            else if (r < MV) dst = out + O_WKS + ((size_t)((r - MP) * WIN + (WIN - 1)) * 2 + kvh) * 64;
                            if (dst) { *(f32x4*)(dst + 4 * g) = o0; *(f32x4*)(dst + 32 + 4 * g) = o1; }
                        } else {
                            *(u32x4*)(vb + (size_t)r * 128 + colb) = pack8(v0, v1);
                            float* dst = nullptr;
                            if (r < MP) { const int t = r & (SEQ - 1); if (t >= SEQ - WIN) dst = out + O_WVP + (size_t)((r >> 13) * WIN + (t - (SEQ - WIN))) * 128; }
                            else if (r < MV) dst = out + O_WVS + (size_t)((r - MP) * WIN + (WIN - 1)) * 128;
                            if (dst) { *(f32x4*)(dst + colb) = v0; *(f32x4*)(dst + colb + 4) = v1; }
                        }
                    } else {
                        if (kind == 1) { const f32x4 o0 = (v0 * cs - v1 * sn) * QSCALE, o1 = (v1 * cs + v0 * sn) * QSCALE; v0 = o0; v1 = o1; }
                        else if (kind == 2) {
#pragma unroll
                            for (int i = 0; i < 4; ++i) { v0[i] = silu_f(v0[i]); v1[i] = silu_f(v1[i]); } }
                        else if (kind == 3) { v0 = v0 * MSCALE; v1 = v1 * MSCALE; }
                        *(u32x4*)(proj + (size_t)r * DIN + pn * BM + bj * HALF + colb) = pack8(v0, v1);
                    }
                }
            }
    }
};
struct EpiOut {
    static constexpr bool PERM = false, AFTER_DRAIN = false;
    const float* xold_p; const float* xold_s; float* xnew; bf16_t* xb; float* rowsq_next;
    __device__ __forceinline__ void operator()(const f32x4 (&acc)[2][2][4][2], const Unit& u, int wr, int wc, int fr, int fq) const {
        const int col0 = u.pn * BM + wc * 32 + 4 * fq;
#pragma unroll
        for (int ai = 0; ai < 2; ++ai) {
            const bool valid = (u.pm * BM + ai * HALF) < MV;
            if (!valid) continue;
#pragma unroll
            for (int m = 0; m < 4; ++m) {
                const int r = u.pm * BM + ai * HALF + wr * 64 + m * 16 + fr;
                const float* xo = r < MP ? xold_p + (size_t)r * DM : xold_s + (size_t)(r - MP) * DM;
                float ss = 0.f;
#pragma unroll
                for (int bj = 0; bj < 2; ++bj)
#pragma unroll
                    for (int n = 0; n < 2; ++n) { const int c = col0 + bj * HALF + n * 16;
                        const f32x4 xn = *(const f32x4*)(xo + c) + acc[ai][bj][m][n];
                        *(f32x4*)(xnew + (size_t)r * DM + c) = xn;
                        u32x2 w; w.x = cvt_pk_bf16(xn[0], xn[1]); w.y = cvt_pk_bf16(xn[2], xn[3]); *(u32x2*)(xb + (size_t)r * DM + c) = w;
                        ss += (xn[0] * xn[0] + xn[1] * xn[1]) + (xn[2] * xn[2] + xn[3] * xn[3]); }
                ss += __shfl_xor(ss, 16); ss += __shfl_xor(ss, 32);
                if (fq == 0) atomicAdd(rowsq_next + r, ss);
            }
        }
    }
};
struct EpiMem {
    static constexpr bool PERM = false, AFTER_DRAIN = false;
    float* omk; float* omv; bf16_t* mkb; bf16_t* mvb; const float* rowsq;
    __device__ __forceinline__ void operator()(const f32x4 (&acc)[2][2][4][2], const Unit& u, int wr, int wc, int fr, int fq) const {
        const int col0 = u.pn * BM + wc * 32 + 4 * fq;
#pragma unroll
        for (int ai = 0; ai < 2; ++ai)
#pragma unroll
            for (int m = 0; m < 4; ++m) {
                const int r = u.pm * BM + ai * HALF + wr * 64 + m * 16 + fr;
                const float rs = __builtin_amdgcn_rsqf(rowsq[r] * (1.0f / 1024.0f) + EPS);
#pragma unroll
                for (int bj = 0; bj < 2; ++bj)
#pragma unroll
                    for (int n = 0; n < 2; ++n) { const int c = col0 + bj * HALF + n * 16; const f32x4 v = acc[ai][bj][m][n] * rs;
                        u32x2 w; w.x = cvt_pk_bf16(v[0], v[1]); w.y = cvt_pk_bf16(v[2], v[3]);
                        if (c < DMEMW) { *(f32x4*)(omk + (size_t)r * DMEMW + c) = v; *(u32x2*)(mkb + (size_t)r * DMEMW + c) = w; }
                        else { *(f32x4*)(omv + (size_t)r * DMEMW + c - DMEMW) = v; *(u32x2*)(mvb + (size_t)r * DMEMW + c - DMEMW) = w; } }
            }
    }
};
template <class Epi, class Sched, bool ALIGN_EPI = false, bool SP2 = false>
__device__ __forceinline__ void gemm_phase(PG8_LAS unsigned char* lds, const Gemm g, const Sched& S, const Epi& E) {
    int tid_ = threadIdx.x; asm volatile("" : "+v"(tid_));
    const int tid = tid_, wid = __builtin_amdgcn_readfirstlane(tid >> 6), lane = tid & 63, wr = wid >> 2, wc = wid & 3, fr = lane & 15, fq = lane >> 4;
    const int K = g.K, nt = K / BK;
    unsigned voffA[2], voffB[2];
#pragma unroll
    for (int i = 0; i < 2; ++i) { int R, C; stage_rc(tid * 16 + i * 8192, R, C); const int Rb = Epi::PERM ? ((R & ~31) + perm32(R & 31)) : R;
        voffA[i] = (unsigned)(R * K + C) * 2u; voffB[i] = (unsigned)(Rb * K + C) * 2u; }
    const size_t kstep = (size_t)(BK * 2);
    const size_t hstep = (size_t)HALF * K * 2;
    const size_t tstep = 2 * hstep;
    const unsigned ldsw = (unsigned)wid * 1024u;
    const int aoff = lds_byte(wr * 64 + fr, fq * 8), boff = lds_byte(wc * 32 + fr, fq * 8);
#define PG8_SA(b, h) (((b) * 2 + (h)) * HTB)
#define PG8_SB(b, h) ((4 + (b) * 2 + (h)) * HTB)
#define PG8_STAGE(bufoff, gbase, voff) do { _Pragma("unroll") for (int _i = 0; _i < 2; ++_i) \
        __builtin_amdgcn_global_load_lds((const unsigned*)((const char*)(gbase) + (voff)[_i]), (PG8_LAS unsigned*)(lds + (bufoff) + ldsw + _i * 8192), 16, 0, 0); } while (0)
#define PG8_LDA(dst, b, h) do { _Pragma("unroll") for (int m = 0; m < 4; ++m) _Pragma("unroll") for (int k = 0; k < 2; ++k) dst[m][k] = *(const PG8_LAS bf16x8*)(lds + PG8_SA(b, h) + aoff + m * 2048 + k * 1024); } while (0)
#define PG8_LDB(dst, b, h) do { _Pragma("unroll") for (int n = 0; n < 2; ++n) _Pragma("unroll") for (int k = 0; k < 2; ++k) dst[n][k] = *(const PG8_LAS bf16x8*)(lds + PG8_SB(b, h) + boff + n * 2048 + k * 1024); } while (0)
#define PG8_MMA(ai, bj, At, Bt) do { __builtin_amdgcn_s_setprio(1); _Pragma("unroll") for (int m = 0; m < 4; ++m) _Pragma("unroll") for (int n = 0; n < 2; ++n) _Pragma("unroll") for (int k = 0; k < 2; ++k) \
        acc[ai][bj][m][n] = __builtin_amdgcn_mfma_f32_16x16x32_bf16(Bt[n][k], At[m][k], acc[ai][bj][m][n], 0, 0, 0); __builtin_amdgcn_s_setprio(0); } while (0)
#define PG8_WAIT_V(n) asm volatile("s_waitcnt vmcnt(" #n ")" ::: "memory")
#define PG8_WAIT_L(n) asm volatile("s_waitcnt lgkmcnt(" #n ")" ::: "memory")
#define PG8_BAR __builtin_amdgcn_s_barrier()
#define PG8_SCHED __builtin_amdgcn_sched_barrier(0)
    Unit cur, nxt; int ui = 0;
    if (!S.next(0, cur)) return;
    f32x4 acc[2][2][4][2];
#pragma unroll
    for (int a = 0; a < 2; ++a)
#pragma unroll
        for (int b = 0; b < 2; ++b)
#pragma unroll
            for (int m = 0; m < 4; ++m)
#pragma unroll
                for (int n = 0; n < 2; ++n) acc[a][b][m][n] = (f32x4){0.f, 0.f, 0.f, 0.f};
    bf16x8 At[4][2], B0[2][2], B1[2][2];
    const char* cA = (const char*)g.A + (size_t)cur.pm * tstep; const char* cB = (const char*)g.Bt + (size_t)cur.pn * tstep;
    S.a_ready(cur);
    if constexpr (SP2) {
        PG8_STAGE(PG8_SB(0, 0), cB, voffB); PG8_STAGE(PG8_SB(0, 1), cB + hstep, voffB); PG8_STAGE(PG8_SA(0, 0), cA, voffA); PG8_STAGE(PG8_SA(0, 1), cA + hstep, voffA);
        if (wr == 1) PG8_BAR;
        PG8_WAIT_V(2); PG8_BAR;
        PG8_STAGE(PG8_SB(1, 0), cB + kstep, voffB); PG8_STAGE(PG8_SA(1, 0), cA + kstep, voffA); PG8_STAGE(PG8_SB(1, 1), cB + hstep + kstep, voffB);
        PG8_WAIT_V(6); PG8_BAR;
    } else {
        PG8_STAGE(PG8_SB(0, 0), cB, voffB); PG8_STAGE(PG8_SA(0, 0), cA, voffA); PG8_STAGE(PG8_SB(0, 1), cB + hstep, voffB); PG8_STAGE(PG8_SA(0, 1), cA + hstep, voffA);
        if (wr == 1) PG8_BAR;
        PG8_WAIT_V(4); PG8_BAR;
        PG8_STAGE(PG8_SB(1, 0), cB + kstep, voffB); PG8_STAGE(PG8_SA(1, 0), cA + kstep, voffA); PG8_STAGE(PG8_SB(1, 1), cB + hstep + kstep, voffB);
        PG8_WAIT_V(6); PG8_BAR;
    }
    for (;;) {
        const bool has_next = S.next(ui + 1, nxt);
        const char* nA = has_next ? (const char*)g.A + (size_t)nxt.pm * tstep : cA; const char* nB = has_next ? (const char*)g.Bt + (size_t)nxt.pn * tstep : cB;
        for (int t = 0; t < nt; t += 2) {
            const bool last = (t == nt - 2);
            const char* a1 = cA + (size_t)(t + 1) * kstep;
            const char* a2 = last ? nA : cA + (size_t)(t + 2) * kstep; const char* b2 = last ? nB : cB + (size_t)(t + 2) * kstep;
            const char* a3 = a2 + kstep; const char* b3 = b2 + kstep;
            if (last && has_next) S.a_ready(nxt);
            if constexpr (SP2) {
            PG8_LDB(B0, 0, 0); PG8_LDB(B1, 0, 1); PG8_SCHED; PG8_LDA(At, 0, 0); PG8_STAGE(PG8_SA(1, 1), a1 + hstep, voffA);
            PG8_WAIT_V(8); PG8_WAIT_L(0); PG8_BAR; PG8_MMA(0, 0, At, B0); PG8_MMA(0, 1, At, B1); PG8_BAR; PG8_SCHED;
            PG8_LDA(At, 0, 1); PG8_STAGE(PG8_SB(0, 0), b2, voffB); PG8_STAGE(PG8_SB(0, 1), b2 + hstep, voffB); PG8_STAGE(PG8_SA(0, 0), a2, voffA);
            PG8_WAIT_V(8); PG8_WAIT_L(0); PG8_BAR; PG8_MMA(1, 0, At, B0); PG8_MMA(1, 1, At, B1); PG8_BAR; PG8_SCHED;
            PG8_LDB(B0, 1, 0); PG8_LDB(B1, 1, 1); PG8_SCHED; PG8_LDA(At, 1, 0); PG8_STAGE(PG8_SA(0, 1), a2 + hstep, voffA);
            PG8_WAIT_V(8); PG8_WAIT_L(0); PG8_BAR; PG8_MMA(0, 0, At, B0); PG8_MMA(0, 1, At, B1); PG8_BAR; PG8_SCHED;
            PG8_LDA(At, 1, 1); PG8_STAGE(PG8_SB(1, 0), b3, voffB); PG8_STAGE(PG8_SB(1, 1), b3 + hstep, voffB); PG8_STAGE(PG8_SA(1, 0), a3, voffA);
            PG8_WAIT_V(8); PG8_WAIT_L(0); PG8_BAR; PG8_MMA(1, 0, At, B0); PG8_MMA(1, 1, At, B1); PG8_BAR; PG8_SCHED;
            } else {
            PG8_LDB(B0, 0, 0); PG8_SCHED; PG8_LDA(At, 0, 0); PG8_STAGE(PG8_SA(1, 1), a1 + hstep, voffA);
            PG8_WAIT_L(8); PG8_BAR; PG8_WAIT_L(0); PG8_MMA(0, 0, At, B0); PG8_BAR; PG8_SCHED;
            PG8_LDB(B1, 0, 1); PG8_STAGE(PG8_SB(0, 0), b2, voffB);
            PG8_BAR; PG8_WAIT_L(0); PG8_MMA(0, 1, At, B1); PG8_BAR;
            PG8_LDA(At, 0, 1); PG8_STAGE(PG8_SA(0, 0), a2, voffA);
            PG8_BAR; PG8_WAIT_L(0); PG8_MMA(1, 0, At, B0); PG8_BAR; PG8_SCHED;
            PG8_STAGE(PG8_SB(0, 1), b2 + hstep, voffB);
            PG8_WAIT_V(6); PG8_BAR; PG8_MMA(1, 1, At, B1); PG8_BAR;
            PG8_LDB(B0, 1, 0); PG8_SCHED; PG8_LDA(At, 1, 0); PG8_STAGE(PG8_SA(0, 1), a2 + hstep, voffA);
            PG8_WAIT_L(8); PG8_BAR; PG8_WAIT_L(0); PG8_MMA(0, 0, At, B0); PG8_BAR; PG8_SCHED;
            PG8_LDB(B1, 1, 1); PG8_STAGE(PG8_SB(1, 0), b3, voffB);
            PG8_BAR; PG8_WAIT_L(0); PG8_MMA(0, 1, At, B1); PG8_BAR;
            PG8_LDA(At, 1, 1); PG8_STAGE(PG8_SA(1, 0), a3, voffA);
            PG8_BAR; PG8_WAIT_L(0); PG8_MMA(1, 0, At, B0); PG8_BAR; PG8_SCHED;
            PG8_STAGE(PG8_SB(1, 1), b3 + hstep, voffB);
            PG8_WAIT_V(6); PG8_BAR; PG8_MMA(1, 1, At, B1); PG8_BAR;
            }
        }
        if constexpr (ALIGN_EPI) { if (wr == 0) PG8_BAR; }
        if constexpr (!Epi::AFTER_DRAIN) { E(acc, cur, wr, wc, fr, fq); S.done(cur); }
        if (!has_next) break;
#pragma unroll
        for (int a = 0; a < 2; ++a)
#pragma unroll
            for (int b = 0; b < 2; ++b)
#pragma unroll
                for (int m = 0; m < 4; ++m)
#pragma unroll
                    for (int n = 0; n < 2; ++n) acc[a][b][m][n] = (f32x4){0.f, 0.f, 0.f, 0.f};
        cur = nxt; cA = nA; cB = nB; ++ui;
        if constexpr (ALIGN_EPI) { if (wr == 1) PG8_BAR; }
    }
    PG8_WAIT_V(0);
    if constexpr (!ALIGN_EPI) { if (wr == 0) PG8_BAR; }
    PG8_BAR;
    if constexpr (Epi::AFTER_DRAIN) { E.fused(acc, cur, wr, wc, fr, fq, lds, wid, lane); S.done(cur); }
#undef PG8_SA
#undef PG8_SB
#undef PG8_STAGE
#undef PG8_LDA
#undef PG8_LDB
#undef PG8_MMA
#undef PG8_WAIT_V
#undef PG8_WAIT_L
#undef PG8_BAR
#undef PG8_SCHED
}
}
constexpr size_t MiB = 1u << 20;
constexpr size_t WS_CTL = 0, CTL_ZERO_BYTES = 2 * MiB;
constexpr size_t WS_ROWSQ = 1 * MiB;
constexpr size_t WS_WIN = 2 * MiB, WIN_STRIDE = 7 * MiB;
constexpr size_t WS_WOUT = 30 * MiB, WOUT_STRIDE = 3 * MiB;
constexpr size_t WS_WMEM = 42 * MiB, WMEM_STRIDE = 2 * MiB;
constexpr size_t WS_WG = 50 * MiB;
constexpr size_t WS_ROPE = 51 * MiB;
constexpr size_t WS_XB = 54 * MiB;
constexpr size_t WS_MEMB = 87 * MiB, WS_RSQM = 88 * MiB;
constexpr size_t WS_PROJ = 90 * MiB;
constexpr size_t WS_KB = 188 * MiB, WS_VB = 193 * MiB;
constexpr size_t WS_Z = 198 * MiB;
constexpr size_t WS_MKB = 247 * MiB, WS_MVB = 249 * MiB;
constexpr size_t WS_AGG = 251 * MiB;
constexpr size_t WS_UC = 256 * MiB, WS_A = 321 * MiB, WS_B = 386 * MiB, WS_END = 451 * MiB;
constexpr int CW_BAR = 4096;

constexpr int RING_OFF = 0, RING_BYTES = 131072;
constexpr int LDSCTL_OFF = RING_BYTES, MISC_OFF = LDSCTL_OFF + 320;
constexpr int LDS_BYTES = 147456;
constexpr int NWAVES = 8;

#define GAS __attribute__((address_space(1)))
#define LAS __attribute__((address_space(3)))
typedef unsigned short bf16;
typedef unsigned v4u __attribute__((ext_vector_type(4)));
typedef float f32x4 __attribute__((ext_vector_type(4)));
typedef GAS unsigned gu32;
#define RLX_AGENT __ATOMIC_RELAXED, __HIP_MEMORY_SCOPE_AGENT
#define LDS_WAIT() asm volatile("s_waitcnt lgkmcnt(0)" ::: "memory")
#define VM_WAIT() asm volatile("s_waitcnt vmcnt(0)" ::: "memory")
__device__ __forceinline__ unsigned f2bf(float f) { unsigned u = __builtin_bit_cast(unsigned, f); return (u + 0x7fffu + ((u >> 16) & 1u)) >> 16; }
__device__ __forceinline__ unsigned pk2(float lo, float hi) { return f2bf(lo) | (f2bf(hi) << 16); }
__device__ __forceinline__ float bf2f(bf16 h) { return __builtin_bit_cast(float, (unsigned)h << 16); }
__device__ __forceinline__ float wave_sum(float v) {
#pragma unroll
    for (int o = 1; o < 64; o <<= 1) v += __shfl_xor(v, o);
    return v;
}
__device__ __forceinline__ float wave_max(float v) {
#pragma unroll
    for (int o = 1; o < 64; o <<= 1) v = fmaxf(v, __shfl_xor(v, o));
    return v;
}
__device__ const float INVF[32] = {1.000000000e+00f, 7.498942614e-01f, 5.623413324e-01f, 4.216965139e-01f, 3.162277639e-01f, 2.371373773e-01f, 1.778279394e-01f, 1.333521307e-01f,
    1.000000015e-01f, 7.498941571e-02f, 5.623413250e-02f, 4.216965288e-02f, 3.162277490e-02f, 2.371373773e-02f, 1.778279431e-02f, 1.333521493e-02f,
    9.999999776e-03f, 7.498941850e-03f, 5.623413250e-03f, 4.216964822e-03f, 3.162277630e-03f, 2.371373586e-03f, 1.778279431e-03f, 1.333521446e-03f,
    1.000000047e-03f, 7.498942432e-04f, 5.623413017e-04f, 4.216965172e-04f, 3.162277571e-04f, 2.371373703e-04f, 1.778279402e-04f, 1.333521504e-04f};
#define XB_TMO      128
#define XB_XCNT(j)  (256  + 64 * (j))
#define XB_XSUB(j)  (1280 + 64 * (j))
#define XB_XGEN(j)  (2304 + 64 * (j))
#define XB_TOP      3328
#define XB_TOPGEN   3392
#define XCD_BAR_WORDS 3456
#define XB_SPIN_CAP (1u << 18)

__device__ __forceinline__ unsigned xb_ld(unsigned* p)              { return __hip_atomic_load(p, __ATOMIC_RELAXED, __HIP_MEMORY_SCOPE_AGENT); }
__device__ __forceinline__ unsigned xb_add(unsigned* p, unsigned v) { return __hip_atomic_fetch_add(p, v, __ATOMIC_RELAXED, __HIP_MEMORY_SCOPE_AGENT); }
__device__ __forceinline__ unsigned xb_xcc_id() { return (unsigned)__builtin_amdgcn_s_getreg((3 << 11) | 20) & 0xFu; }
#define XB_SPIN(cond, bar) do { unsigned _sp = 0; while (cond) { __builtin_amdgcn_s_sleep(1); \
    if ((++_sp & 255u) == 0u) { if (xb_ld(&(bar)[XB_TMO])) break; if (_sp > XB_SPIN_CAP) { atomicAdd(&(bar)[XB_TMO], 1u); break; } } } } while (0)

struct XcdBarrier {
    unsigned* bar; unsigned x;
    volatile LAS unsigned* st;
};

__device__ __forceinline__ XcdBarrier xcd_barrier_post(unsigned* bar, volatile LAS unsigned* st) {
    XcdBarrier b; b.bar = bar; b.x = xb_xcc_id(); b.st = st;
    if (threadIdx.x == 0) (void)xb_add(&bar[XB_XCNT(b.x)], 1u);
    return b;
}
__device__ __forceinline__ void xcd_barrier_complete(unsigned* bar, unsigned x, unsigned& nloc, unsigned& nx) {
    const unsigned G = gridDim.x * gridDim.y * gridDim.z;
    unsigned sum, cnt, mine, sp = 0u;
    for (;;) {
        sum = 0u; cnt = 0u; mine = 0u;
#pragma unroll
        for (unsigned j = 0; j < 16; ++j) { const unsigned c = xb_ld(&bar[XB_XCNT(j)]); sum += c; cnt += (c > 0u) ? 1u : 0u; mine = (j == x) ? c : mine; }
        if (sum == G) break;
        __builtin_amdgcn_s_sleep(1);
        if ((++sp & 255u) == 0u) { if (xb_ld(&bar[XB_TMO])) break; if (sp > XB_SPIN_CAP) { atomicAdd(&bar[XB_TMO], 1u); break; } }
    }
    nloc = mine > 0u ? mine : 1u; nx = cnt > 0u ? cnt : 1u;
}

__device__ __forceinline__ void xcd_barrier(const XcdBarrier& b) {
    asm volatile("s_waitcnt vmcnt(0)" ::: "memory");
    __syncthreads();
    if (threadIdx.x == 0) {
        unsigned* bar = b.bar;
        __builtin_amdgcn_s_waitcnt(0);
        unsigned nloc = b.st[0], nx = b.st[1];
        if (nloc == 0u) { xcd_barrier_complete(bar, b.x, nloc, nx); b.st[0] = nloc; b.st[1] = nx; }
        const unsigned old = xb_add(&bar[XB_XSUB(b.x)], 1u);
        const unsigned gen = old / nloc;
        if (old + 1u == (gen + 1u) * nloc) {
            __builtin_amdgcn_fence(__ATOMIC_RELEASE, "agent");
            asm volatile("s_waitcnt vmcnt(0)" ::: "memory");
            const unsigned og = xb_add(&bar[XB_TOP], 1u);
            const unsigned tg = og / nx;
            if (og + 1u == (tg + 1u) * nx) xb_add(&bar[XB_TOPGEN], 1u);
            else XB_SPIN(xb_ld(&bar[XB_TOPGEN]) == tg, bar);
            __builtin_amdgcn_fence(__ATOMIC_ACQUIRE, "agent");
            xb_add(&bar[XB_XGEN(b.x)], 1u);
            asm volatile("s_waitcnt vmcnt(0)" ::: "memory");
        } else {
            XB_SPIN(xb_ld(&bar[XB_XGEN(b.x)]) == gen, bar);
            __builtin_amdgcn_fence(__ATOMIC_ACQUIRE, "agent");
            asm volatile("s_waitcnt vmcnt(0)" ::: "memory");
        }
    }
    __syncthreads();
}
enum { I_XP = 0, I_XS, I_CMK, I_CMV, I_STH, I_STC, I_CWK, I_CWV, I_MEMP, I_NORMG, I_WIN, I_WOUT, I_MEMNG, I_WMEMKV, I_CONVW, I_CONVB, I_WA, I_BA, I_WX, I_BX, I_LAM, I_KVNG, I_WKV, I_SINKS, I_FINALG, N_IN };
struct Args { const float* in[N_IN]; float* out; unsigned char* ws; int ph_lo, ph_hi; };

struct Ids { int tid, lane, wave, gw, NGW, gtid, GT; };
__device__ __forceinline__ Ids make_ids() {
    Ids I; int tid = threadIdx.x; asm volatile("" : "+v"(tid));
    I.tid = tid; I.lane = tid & 63; I.wave = __builtin_amdgcn_readfirstlane(tid >> 6);
    const int G = gridDim.x, bx = blockIdx.x; const int vcu = (G % 8 == 0) ? (bx % 8) * (G / 8) + bx / 8 : bx;
    I.gw = vcu * 8 + I.wave; I.NGW = G * 8; I.gtid = vcu * 512 + tid; I.GT = G * 512; return I;
}

__device__ __forceinline__ int permpos(int d) { return d < 32 ? 8 * (d >> 2) + (d & 3) : 8 * ((d - 32) >> 2) + 4 + (d & 3); }
__device__ __forceinline__ int permdim(int p) { return 32 * ((p >> 2) & 1) + 4 * (p >> 3) + (p & 3); }
__device__ __forceinline__ void p0_transpose_item(const float* W, int K, int N, const float* gs, bf16* WT, int row_off, int perm_cols, LAS float* scr, int item, int lane) {
    const int nblk = N / 32, kb = item / nblk, nb = item % nblk, k0 = 64 * kb, n0 = 32 * nb;
#pragma unroll 8
    for (int i = 0; i < 32; ++i) { const int kk = 2 * i + (lane >> 5); const float s = gs ? gs[k0 + kk] : 1.0f; scr[kk * 33 + (lane & 31)] = W[(size_t)(k0 + kk) * N + n0 + (lane & 31)] * s; }
    LDS_WAIT(); asm volatile("" ::: "memory");
    const int c = lane & 7;
#pragma unroll
    for (int j = 0; j < 4; ++j) { const int n = (lane >> 3) + 8 * j; const LAS float* s = scr + (8 * c) * 33 + n;
        v4u o; o.x = pk2(s[0 * 33], s[1 * 33]); o.y = pk2(s[2 * 33], s[3 * 33]); o.z = pk2(s[4 * 33], s[5 * 33]); o.w = pk2(s[6 * 33], s[7 * 33]);
        const int nn = n0 + n; const int row = nn < perm_cols ? (nn & ~63) + permpos(nn & 63) : nn;
        *(GAS v4u*)(WT + (size_t)(row_off + row) * K + k0 + 8 * c) = o; }
    LDS_WAIT(); asm volatile("" ::: "memory");
}
__device__ __forceinline__ void row_to_bf16(const float* xrow, bf16* orow, float* sq, int lane) {
    const GAS f32x4* xr = (const GAS f32x4*)xrow + lane;
    f32x4 v[4]; float s = 0.f;
#pragma unroll
    for (int j = 0; j < 4; ++j) { v[j] = xr[64 * j]; s += (v[j].x * v[j].x + v[j].y * v[j].y) + (v[j].z * v[j].z + v[j].w * v[j].w); }
    s = wave_sum(s);
    GAS unsigned long long* o8 = (GAS unsigned long long*)orow + lane;
#pragma unroll
    for (int j = 0; j < 4; ++j) o8[64 * j] = (unsigned long long)pk2(v[j].x, v[j].y) | ((unsigned long long)pk2(v[j].z, v[j].w) << 32);
    if (lane == 0) *sq = s;
}
__device__ __forceinline__ void sincos_f32arg(float angf, float& c, float& s) {
    const double x = (double)angf;
    const double kq = __builtin_rint(x * 0.63661977236758134308);
    double r = __builtin_fma(-kq, 1.57079632679489655800e+00, x); r = __builtin_fma(-kq, 6.12323399573676603587e-17, r);
    const double r2 = r * r;
    double sp = 1.0 / 6227020800.0; sp = sp * r2 - 1.0 / 39916800.0; sp = sp * r2 + 1.0 / 362880.0; sp = sp * r2 - 1.0 / 5040.0; sp = sp * r2 + 1.0 / 120.0; sp = sp * r2 - 1.0 / 6.0; sp = sp * r2 + 1.0; sp = sp * r;
    double cp = -1.0 / 87178291200.0; cp = cp * r2 + 1.0 / 479001600.0; cp = cp * r2 - 1.0 / 3628800.0; cp = cp * r2 + 1.0 / 40320.0; cp = cp * r2 - 1.0 / 720.0; cp = cp * r2 + 1.0 / 24.0; cp = cp * r2 - 0.5; cp = cp * r2 + 1.0;
    const int q = ((int)kq) & 3;
    const double cc = (q == 0) ? cp : (q == 1) ? -sp : (q == 2) ? -cp : sp;
    const double ss = (q == 0) ? sp : (q == 1) ? cp : (q == 2) ? -sp : -cp;
    c = (float)cc; s = (float)ss;
}
__device__ __forceinline__ void p0_prologue(const Args& A, LAS unsigned char* lds) {
    const Ids I = make_ids();
    unsigned char* ws = A.ws;
    LAS float* scr = (LAS float*)(lds + RING_OFF + I.wave * 16384);
    constexpr int IT_IN = (DM / 64) * (DIN / 32), IT_KV = (DM / 64) * (256 / 32), IT_OUT = (DCAT / 64) * (DM / 32), IT_MEM = (DM / 64) * (DM / 32);
    constexpr int NITEMS = DEPTH * IT_IN + IT_KV + DEPTH * IT_OUT + DEPTH * IT_MEM;
    for (int it = I.gw; it < NITEMS; it += I.NGW) {
        int r = it;
        if (r < DEPTH * IT_IN) { const int l = r / IT_IN; r -= l * IT_IN;
            p0_transpose_item(A.in[I_WIN] + (size_t)l * DM * DIN, DM, DIN, A.in[I_NORMG] + l * DM, (bf16*)(ws + WS_WIN + l * WIN_STRIDE), 0, l >= N_A ? DMAIN : 0, scr, r, I.lane); continue; }
        r -= DEPTH * IT_IN;
        if (r < IT_KV) { p0_transpose_item(A.in[I_WKV], DM, 256, A.in[I_KVNG], (bf16*)(ws + WS_WIN + N_A * WIN_STRIDE), DIN, 128, scr, r, I.lane); continue; }
        r -= IT_KV;
        if (r < DEPTH * IT_OUT) { const int l = r / IT_OUT; r -= l * IT_OUT;
            p0_transpose_item(A.in[I_WOUT] + (size_t)l * DCAT * DM, DCAT, DM, nullptr, (bf16*)(ws + WS_WOUT + l * WOUT_STRIDE), 0, 0, scr, r, I.lane); continue; }
        r -= DEPTH * IT_OUT;
        { const int l = r / IT_MEM; r -= l * IT_MEM;
            p0_transpose_item(A.in[I_WMEMKV] + (size_t)l * DM * DM, DM, DM, A.in[I_MEMNG] + l * DM, (bf16*)(ws + WS_WMEM + l * WMEM_STRIDE), 0, 0, scr, r, I.lane); }
    }
    bf16* xb = (bf16*)(ws + WS_XB); float* rowsq0 = (float*)(ws + WS_ROWSQ);
    for (int m = I.gw; m < MPAD + 512; m += I.NGW) {
        if (m < MP) row_to_bf16(A.in[I_XP] + (size_t)m * DM, xb + (size_t)m * DM, rowsq0 + m, I.lane);
        else if (m < MV) row_to_bf16(A.in[I_XS] + (size_t)(m - MP) * DM, xb + (size_t)m * DM, rowsq0 + m, I.lane);
        else if (m < MPAD) { GAS unsigned long long* o8 = (GAS unsigned long long*)(xb + (size_t)m * DM) + I.lane;
#pragma unroll
            for (int j = 0; j < 4; ++j) o8[64 * j] = 0ull; }
        else { const int mm = m - MPAD; row_to_bf16(A.in[I_MEMP] + (size_t)mm * DM, (bf16*)(ws + WS_MEMB) + (size_t)mm * DM, (float*)(ws + WS_RSQM) + mm, I.lane); }
    }
    float* rope = (float*)(ws + WS_ROPE);
    for (int e = I.gtid; e < (SEQ + 1) * 32; e += I.GT) { const int pos = e >> 5, i = e & 31; float c, s; sincos_f32arg((float)pos * INVF[i], c, s); rope[(size_t)pos * 64 + i] = c; rope[(size_t)pos * 64 + 32 + i] = s; }
    for (int e = I.gtid; e < MS * 127 * 32; e += I.GT) { const int sb = e / (127 * 32), rem = e - sb * (127 * 32);
        const f32x4 kv = *(const f32x4*)(A.in[I_CWK] + (size_t)sb * WIN * 128 + 128 + rem * 4); *(f32x4*)(A.out + O_WKS + (size_t)sb * WIN * 128 + rem * 4) = kv;
        const f32x4 vv = *(const f32x4*)(A.in[I_CWV] + (size_t)sb * WIN * 128 + 128 + rem * 4); *(f32x4*)(A.out + O_WVS + (size_t)sb * WIN * 128 + rem * 4) = vv; }
}

__device__ __forceinline__ void conv_naive(const Args& A, int l) {
    const Ids I = make_ids();
    const bf16* proj = (const bf16*)(A.ws + WS_PROJ); float* ucb = (float*)(A.ws + WS_UC);
    const float* cw = A.in[I_CONVW] + (size_t)l * 4 * DMAIN;
    for (size_t idx = I.gtid; idx < (size_t)MV * DMAIN; idx += I.GT) {
        const int r = (int)(idx >> 10), ch = (int)(idx & 1023);
        const float cb = A.in[I_CONVB][l * DMAIN + ch], w0 = cw[ch], w1 = cw[DMAIN + ch], w2 = cw[2 * DMAIN + ch], w3 = cw[3 * DMAIN + ch];
        const float u3 = bf2f(proj[(size_t)r * DIN + ch]);
        float uc;
        if (r < MP) { const int t = r & (SEQ - 1), b = r >> 13;
            const float u0 = t >= 3 ? bf2f(proj[(size_t)(r - 3) * DIN + ch]) : 0.f, u1 = t >= 2 ? bf2f(proj[(size_t)(r - 2) * DIN + ch]) : 0.f, u2 = t >= 1 ? bf2f(proj[(size_t)(r - 1) * DIN + ch]) : 0.f;
            uc = cb + u0 * w0; uc += u1 * w1; uc += u2 * w2; uc += u3 * w3;
            if (t >= SEQ - 3) A.out[O_CP + ((size_t)(l * NB + b) * 3 + (t - (SEQ - 3))) * DMAIN + ch] = u3;
        } else { const int sb = r - MP; const float* sc = A.in[I_STC] + (size_t)(l * MS + sb) * 3 * DMAIN;
            const float c0 = sc[ch], c1 = sc[DMAIN + ch], c2 = sc[2 * DMAIN + ch];
            uc = cb + c0 * w0; uc += c1 * w1; uc += c2 * w2; uc += u3 * w3;
            float* oc = A.out + O_CS + (size_t)(l * MS + sb) * 3 * DMAIN; oc[ch] = c1; oc[DMAIN + ch] = c2; oc[2 * DMAIN + ch] = u3; }
        ucb[idx] = uc;
    }
}
__device__ __forceinline__ void gates_naive(const Args& A, int l) {
    const Ids I = make_ids();
    const float* ucb = (const float*)(A.ws + WS_UC); float* ab = (float*)(A.ws + WS_A); float* bb = (float*)(A.ws + WS_B);
    for (size_t idx = I.gtid; idx < (size_t)MV * DMAIN; idx += I.GT) {
        const int r = (int)(idx >> 10), ch = (int)(idx & 1023), blk = ch >> 6, co = ch & 63;
        const float* ucr = ucb + (size_t)r * DMAIN + blk * 64;
        const float* wa = A.in[I_WA] + (size_t)(l * 16 + blk) * 4096 + co; const float* wx = A.in[I_WX] + (size_t)(l * 16 + blk) * 4096 + co;
        float ra = A.in[I_BA][l * DMAIN + ch], ri = A.in[I_BX][l * DMAIN + ch];
#pragma unroll 8
        for (int ci = 0; ci < 64; ++ci) { const float v = ucr[ci]; ra += v * wa[ci * 64]; ri += v * wx[ci * 64]; }
        const float rg = 1.0f / (1.0f + expf(-ra)), ig = 1.0f / (1.0f + expf(-ri));
        const float sp = log1pf(expf(-A.in[I_LAM][l * DMAIN + ch]));
        const float la = -8.0f * rg * sp, a = expf(la), bt = sqrtf(-expm1f(2.0f * la)) * (ig * ucr[co]);
        ab[idx] = a; bb[idx] = bt;
    }
}
__device__ __forceinline__ void scan_naive(const Args& A, int l) {
    const Ids I = make_ids();
    const float* ab = (const float*)(A.ws + WS_A); float* bb = (float*)(A.ws + WS_B);
    if (I.gtid < NB * DMAIN) { const int b = I.gtid >> 10, ch = I.gtid & 1023; float h = 0.f; const size_t base = (size_t)b * SEQ * DMAIN + ch;
        for (int t0 = 0; t0 < SEQ; t0 += 8) { float a[8], x[8];
#pragma unroll
            for (int j = 0; j < 8; ++j) { a[j] = ab[base + (size_t)(t0 + j) * DMAIN]; x[j] = bb[base + (size_t)(t0 + j) * DMAIN]; }
#pragma unroll
            for (int j = 0; j < 8; ++j) { h = a[j] * h + x[j]; bb[base + (size_t)(t0 + j) * DMAIN] = h; } }
        A.out[O_HP + (size_t)(l * NB + b) * DMAIN + ch] = h; }
    for (int idx = I.gtid; idx < MS * DMAIN; idx += I.GT) { const int sb = idx >> 10, ch = idx & 1023; const size_t e = (size_t)(MP + sb) * DMAIN + ch;
        const float h = ab[e] * A.in[I_STH][(size_t)(l * MS + sb) * DMAIN + ch] + bb[e]; bb[e] = h; A.out[O_HS + (size_t)(l * MS + sb) * DMAIN + ch] = h; }
}
__device__ __forceinline__ void zmain_naive(const Args& A) {
    const Ids I = make_ids();
    const bf16* proj = (const bf16*)(A.ws + WS_PROJ); const float* hb = (const float*)(A.ws + WS_B); bf16* z = (bf16*)(A.ws + WS_Z);
    for (size_t idx = I.gtid; idx < (size_t)MV * DMAIN; idx += I.GT) { const int r = (int)(idx >> 10), ch = (int)(idx & 1023);
        z[(size_t)r * DCAT + ch] = (bf16)f2bf(hb[idx] * bf2f(proj[(size_t)r * DIN + DMAIN + ch])); }
}
__device__ __forceinline__ void memattn_naive(const Args& A, int l, LAS unsigned char* lds) {
    const Ids I = make_ids();
    const bf16* proj = (const bf16*)(A.ws + WS_PROJ); bf16* z = (bf16*)(A.ws + WS_Z);
    LAS float* lq = (LAS float*)(lds + I.wave * 2048); LAS float* lp = lq + 128;
    for (int task = I.gw; task < MV * MEMH; task += I.NGW) {
        const int r = task >> 2, mh = task & 3, lane = I.lane;
        lq[lane] = bf2f(proj[(size_t)r * DIN + 2048 + mh * 128 + lane]); lq[lane + 64] = bf2f(proj[(size_t)r * DIN + 2048 + mh * 128 + 64 + lane]);
        LDS_WAIT(); asm volatile("" ::: "memory");
        float s[4];
        if (r < MP) { const int b = r >> 13;
#pragma unroll
            for (int j = 0; j < 4; ++j) { const int m = lane + 64 * j; const bf16* kr = (const bf16*)(A.ws + WS_MKB) + ((size_t)(l * 512 + b * 256 + m)) * 512 + mh * 128; float acc = 0.f;
                _Pragma("unroll 8") for (int d = 0; d < 128; ++d) acc += lq[d] * bf2f(kr[d]);
                s[j] = acc; }
        } else { const int sb = r - MP;
#pragma unroll
            for (int j = 0; j < 4; ++j) { const int m = lane + 64 * j; const float* kr = A.in[I_CMK] + (((size_t)(l * MS + sb) * NMEM + m) * MEMH + mh) * MEMHD; float acc = 0.f;
                _Pragma("unroll 8") for (int d = 0; d < 128; ++d) acc += lq[d] * kr[d];
                s[j] = acc; }
        }
        const float mx = wave_max(fmaxf(fmaxf(s[0], s[1]), fmaxf(s[2], s[3])));
        float p[4], ps = 0.f;
#pragma unroll
        for (int j = 0; j < 4; ++j) { p[j] = exp2f(s[j] - mx); ps += p[j]; }
        ps = wave_sum(ps); const float inv = 1.0f / ps;
#pragma unroll
        for (int j = 0; j < 4; ++j) lp[lane + 64 * j] = p[j] * inv;
        LDS_WAIT(); asm volatile("" ::: "memory");
#pragma unroll
        for (int dd = 0; dd < 2; ++dd) { const int d = lane + 64 * dd; float acc = 0.f;
            if (r < MP) { const int b = r >> 13; const bf16* vr = (const bf16*)(A.ws + WS_MVB) + ((size_t)(l * 512 + b * 256)) * 512 + mh * 128 + d;
                _Pragma("unroll 8") for (int m = 0; m < NMEM; ++m) acc += lp[m] * bf2f(vr[(size_t)m * 512]); }
            else { const int sb = r - MP; const float* vr = A.in[I_CMV] + (((size_t)(l * MS + sb) * NMEM) * MEMH + mh) * MEMHD + d;
                _Pragma("unroll 8") for (int m = 0; m < NMEM; ++m) acc += lp[m] * vr[(size_t)m * MEMH * MEMHD]; }
            z[(size_t)r * DCAT + DMAIN + mh * 128 + d] = (bf16)f2bf(acc * bf2f(proj[(size_t)r * DIN + 2560 + mh * 128 + d])); }
        LDS_WAIT(); asm volatile("" ::: "memory");
    }
}
__device__ __forceinline__ void attn_naive(const Args& A, int l, LAS unsigned char* lds) {
    const Ids I = make_ids();
    const bf16* proj = (const bf16*)(A.ws + WS_PROJ); bf16* z = (bf16*)(A.ws + WS_Z);
    const bf16* kb = (const bf16*)(A.ws + WS_KB); const bf16* vb = (const bf16*)(A.ws + WS_VB);
    LAS float* lq = (LAS float*)(lds + I.wave * 2048); LAS float* lp = lq + 128;
    for (int task = I.gw; task < MV * NHEADS; task += I.NGW) {
        const int r = task >> 4, h = task & 15, kvh = h >> 3, lane = I.lane;
        lq[lane] = bf2f(proj[(size_t)r * DIN + h * 64 + lane]);
        LDS_WAIT(); asm volatile("" ::: "memory");
        const float sink2 = A.in[I_SINKS][(l - N_A) * NHEADS + h] * LOG2E;
        float s[2]; bool valid[2];
        if (r < MP) { const int t = r & (SEQ - 1);
#pragma unroll
            for (int j = 0; j < 2; ++j) { const int tt = t - 127 + lane + 64 * j; valid[j] = tt >= 0; float acc = 0.f;
                if (valid[j]) { const bf16* kr = kb + (size_t)(r - 127 + lane + 64 * j) * 128 + kvh * 64; _Pragma("unroll 8") for (int p = 0; p < 64; ++p) acc += lq[p] * bf2f(kr[p]); }
                s[j] = acc; }
        } else { const int sb = r - MP;
#pragma unroll
            for (int j = 0; j < 2; ++j) { const int jj = lane + 64 * j; valid[j] = true; float acc = 0.f;
                if (jj < 127) { const float* kr = A.in[I_CWK] + ((size_t)(sb * WIN + jj + 1) * NKV + kvh) * HD; _Pragma("unroll 8") for (int p = 0; p < 64; ++p) acc += lq[p] * kr[permdim(p)]; }
                else { const bf16* kr = kb + (size_t)r * 128 + kvh * 64; _Pragma("unroll 8") for (int p = 0; p < 64; ++p) acc += lq[p] * bf2f(kr[p]); }
                s[j] = acc; }
        }
        float mx = fmaxf(valid[0] ? s[0] : -3.0e38f, valid[1] ? s[1] : -3.0e38f); mx = fmaxf(wave_max(mx), sink2);
        float p0 = valid[0] ? exp2f(s[0] - mx) : 0.f, p1 = valid[1] ? exp2f(s[1] - mx) : 0.f;
        const float den = wave_sum(p0 + p1) + exp2f(sink2 - mx);
        lp[lane] = p0; lp[lane + 64] = p1;
        LDS_WAIT(); asm volatile("" ::: "memory");
        float acc = 0.f; const int d = lane;
        if (r < MP) { const int t = r & (SEQ - 1); const int j0 = t >= 127 ? 0 : 127 - t;
            _Pragma("unroll 4") for (int j = j0; j < 128; ++j) acc += lp[j] * bf2f(vb[(size_t)(r - 127 + j) * 128 + kvh * 64 + d]); }
        else { const int sb = r - MP;
            _Pragma("unroll 4") for (int j = 0; j < 127; ++j) acc += lp[j] * A.in[I_CWV][((size_t)(sb * WIN + j + 1) * NKV + kvh) * HD + d];
            acc += lp[127] * bf2f(vb[(size_t)r * 128 + kvh * 64 + d]); }
        z[(size_t)r * DCAT + h * 64 + d] = (bf16)f2bf(acc / den * bf2f(proj[(size_t)r * DIN + DMAIN + h * 64 + d]));
        LDS_WAIT(); asm volatile("" ::: "memory");
    }
}
__device__ __forceinline__ void final_norm(const Args& A) {
    const Ids I = make_ids();
    const float* rsq = (const float*)(A.ws + WS_ROWSQ) + 4 * MPAD;
    for (int m = I.gw; m < MV; m += I.NGW) {
        const float rs = 1.0f / sqrtf(rsq[m] * (1.0f / 1024.0f) + EPS);
        GAS f32x4* xr = (GAS f32x4*)(A.out + (size_t)m * DM) + I.lane; const GAS f32x4* gr = (const GAS f32x4*)A.in[I_FINALG] + I.lane;
#pragma unroll
        for (int j = 0; j < 4; ++j) { const f32x4 v = xr[64 * j] * rs * gr[64 * j]; xr[64 * j] = v; }
    }
}
#ifndef MK_PER_PHASE
#define MK_PER_PHASE 0
#endif
constexpr int NPHASES = 2 + N_A * 6 + (DEPTH - N_A) * 3 + 1;

__global__ void __launch_bounds__(NWAVES * 64, 2) mk_fwd(Args args) {
    extern __shared__ __attribute__((aligned(16))) unsigned char lds_raw[];
    LAS unsigned char* lds = (LAS unsigned char*)lds_raw;
    const int G = gridDim.x, bx = blockIdx.x;
    unsigned char* ws = args.ws;
    for (int u = threadIdx.x; u < (LDS_BYTES - LDSCTL_OFF) / 4; u += NWAVES * 64) ((LAS unsigned*)(lds + LDSCTL_OFF))[u] = 0u;
    __syncthreads();
    XcdBarrier bar; bar.bar = (unsigned*)(ws + WS_CTL) + CW_BAR; bar.x = 0; bar.st = nullptr;
    if (!MK_PER_PHASE) bar = xcd_barrier_post((unsigned*)(ws + WS_CTL) + CW_BAR, (volatile LAS unsigned*)(lds + MISC_OFF) + 8);
    const int lo = args.ph_lo, hi = args.ph_hi;
    int ph = 0;
#define PH_BEGIN if (ph >= lo && ph < hi) {
#define PH_END   if (!MK_PER_PHASE && ph + 1 < hi) xcd_barrier(bar); } ++ph;

    bf16* xb = (bf16*)(ws + WS_XB); bf16* proj = (bf16*)(ws + WS_PROJ); bf16* zb = (bf16*)(ws + WS_Z);
    float* rowsq = (float*)(ws + WS_ROWSQ);

    PH_BEGIN p0_prologue(args, lds); PH_END
    PH_BEGIN
#pragma unroll 1
        for (int l = 0; l < DEPTH; ++l) {
            pg8::Gemm g{(const bf16*)(ws + WS_MEMB), (const bf16*)(ws + WS_WMEM + l * WMEM_STRIDE), 512, DM, DM}; pg8::StaticOrder S; S.init(512, DM, G, bx);
            pg8::EpiMem E{args.out + O_MK + (size_t)l * 512 * 512, args.out + O_MV + (size_t)l * 512 * 512, (bf16*)(ws + WS_MKB) + (size_t)l * 512 * 512, (bf16*)(ws + WS_MVB) + (size_t)l * 512 * 512, (const float*)(ws + WS_RSQM)};
            pg8::gemm_phase<pg8::EpiMem, pg8::StaticOrder, true, true>(lds + RING_OFF, g, S, E);
        }
    PH_END
#pragma unroll 1
    for (int l = 0; l < DEPTH; ++l) {
        PH_BEGIN
            const int N = (l == N_A) ? DIN + 256 : DIN;
            pg8::Gemm g{xb, (const bf16*)(ws + WS_WIN + l * WIN_STRIDE), MPAD, N, DM}; pg8::StaticOrder S; S.init(MPAD, N, G, bx);
            pg8::EpiIn E{proj, (bf16*)(ws + WS_KB), (bf16*)(ws + WS_VB), rowsq + (size_t)l * MPAD, (const float*)(ws + WS_ROPE), args.out, l >= N_A ? 1 : 0};
            pg8::gemm_phase<pg8::EpiIn, pg8::StaticOrder, true, true>(lds + RING_OFF, g, S, E);
        PH_END
        if (l < N_A) {
            PH_BEGIN conv_naive(args, l); PH_END
            PH_BEGIN gates_naive(args, l); PH_END
            PH_BEGIN scan_naive(args, l); PH_END
            PH_BEGIN zmain_naive(args); memattn_naive(args, l, lds); PH_END
        } else {
            PH_BEGIN attn_naive(args, l, lds); memattn_naive(args, l, lds); PH_END
        }
        PH_BEGIN
            pg8::Gemm g{zb, (const bf16*)(ws + WS_WOUT + l * WOUT_STRIDE), MPAD, DM, DCAT}; pg8::StaticOrder S; S.init(MPAD, DM, G, bx);
            pg8::EpiOut E{l == 0 ? args.in[I_XP] : args.out + O_YP, l == 0 ? args.in[I_XS] : args.out + O_YS, args.out, xb, rowsq + (size_t)(l + 1) * MPAD};
            pg8::gemm_phase<pg8::EpiOut, pg8::StaticOrder, true, true>(lds + RING_OFF, g, S, E);
        PH_END
    }
    PH_BEGIN final_norm(args); PH_END
#undef PH_BEGIN
#undef PH_END
}

extern "C" void kernel_launch(void* const* d_in, const int* in_sizes, int n_in, void* d_out, int out_size, void* d_ws, size_t ws_size, hipStream_t stream) {
    static int grid = 0;
    if (grid == 0) {
        if (n_in != N_IN || (size_t)out_size != O_END || ws_size < WS_END) { fprintf(stderr, "kernel_launch: unexpected shapes (n_in %d out %d ws %zu); nothing launched\n", n_in, out_size, ws_size); grid = -1; return; }
        int dev = 0, cus = 0, per_cu = 0;
        if (hipGetDevice(&dev) != hipSuccess || hipDeviceGetAttribute(&cus, hipDeviceAttributeMultiprocessorCount, dev) != hipSuccess) { grid = -1; return; }
        if (hipFuncSetAttribute((const void*)mk_fwd, hipFuncAttributeMaxDynamicSharedMemorySize, LDS_BYTES) != hipSuccess) { fprintf(stderr, "kernel_launch: hipFuncSetAttribute failed\n"); grid = -1; return; }
        if (hipOccupancyMaxActiveBlocksPerMultiprocessor(&per_cu, (const void*)mk_fwd, NWAVES * 64, LDS_BYTES) != hipSuccess || per_cu < 1) { fprintf(stderr, "kernel_launch: occupancy query reports %d\n", per_cu); }
        (void)hipGetLastError();
        grid = cus;
    }
    if (grid < 0) return;
    if (hipMemsetAsync((char*)d_ws + WS_CTL, 0, CTL_ZERO_BYTES, stream) != hipSuccess) return;
    Args a{};
    for (int i = 0; i < N_IN; ++i) a.in[i] = (const float*)d_in[i];
    a.out = (float*)d_out; a.ws = (unsigned char*)d_ws;
#if MK_PER_PHASE
    for (int p = 0; p < NPHASES; ++p) { a.ph_lo = p; a.ph_hi = p + 1; hipLaunchKernelGGL(mk_fwd, dim3(grid), dim3(NWAVES * 64), LDS_BYTES, stream, a); }
#else
    a.ph_lo = 0; a.ph_hi = NPHASES; hipLaunchKernelGGL(mk_fwd, dim3(grid), dim3(NWAVES * 64), LDS_BYTES, stream, a);
#endif
}
```

```cpp
#include <hip/hip_runtime.h>
#include <cstdio>
#include <cstdint>
constexpr int DM = 1024;
constexpr int SEQ = 8192, NB = 2;
constexpr int MP = NB * SEQ;
constexpr int MS = 128;
constexpr int MV = MP + MS;
constexpr int MPAD = 16640;
constexpr int DEPTH = 4, N_A = 2;
constexpr int DIN = 3072, DCAT = 1536, DMAIN = 1024, DMEMW = 512;
constexpr int NMEM = 256, MEMH = 4, MEMHD = 128;
constexpr int NHEADS = 16, HD = 64, NKV = 2, WIN = 128;
constexpr float EPS = 1e-6f;
constexpr float LOG2E = 1.4426950408889634f;
constexpr float QSCALE = 0.125f * LOG2E;
constexpr float MSCALE = 0.08838834764831845f * LOG2E;
constexpr size_t O_YP = 0, O_YS = 16777216, O_MK = 16908288, O_MV = 17956864, O_HP = 19005440, O_CP = 19009536, O_WKP = 19021824, O_WVP = 19054592,
                 O_HS = 19087360, O_CS = 19349504, O_WKS = 20135936, O_WVS = 22233088, O_END = 24330240;
#define MK_PER_PHASE 0
namespace pg8 {
#define PG8_LAS __attribute__((address_space(3)))
typedef unsigned short bf16_t;
typedef short bf16x8 __attribute__((ext_vector_type(8)));
typedef float f32x4 __attribute__((ext_vector_type(4)));
typedef unsigned u32x4 __attribute__((ext_vector_type(4)));
constexpr int BM = 256, BK = 64, HALF = 128, HTB = HALF * BK * 2  , STAGE_BYTES = 8 * HTB, NXCD = 8, WGM = 8;

__host__ __device__ __forceinline__ int lds_byte(int r, int c) { const int st = (r >> 4) * 2 + (c >> 5), rr = r & 15, cc = c & 31, ob = rr * 64 + cc * 2; return st * 1024 + (ob ^ (((ob >> 9) & 1) << 5)); }
__host__ __device__ __forceinline__ void stage_rc(int b, int& R, int& C) { const int st = b / 1024, sb = b % 1024, swz = sb ^ (((sb >> 9) & 1) << 5); R = (st >> 1) * 16 + swz / 64; C = (st & 1) * 32 + (swz % 64) / 2; }
__host__ __device__ __forceinline__ int perm32(int rho) { const int n = rho >> 4, i = rho & 15; return 8 * (i >> 2) + 4 * n + (i & 3); }

struct Unit { int pm, pn; };
struct Gemm { const bf16_t* A; const bf16_t* Bt; int M, N, K; };

struct StaticOrder {
    int nM, nN, nwg, G, c;
    __host__ __device__ void init(int M, int N, int G_, int c_) { nM = M / BM; nN = N / BM; nwg = nM * nN; G = G_; c = c_; }
    __host__ __device__ bool next(int i, Unit& u) const {
        const long L = (long)i * G + c; if (L >= nwg) return false;
        int wgid = (int)L; { const int q = nwg / NXCD, r = nwg % NXCD, xcd = wgid % NXCD, off = wgid / NXCD; wgid = (xcd < r ? xcd * (q + 1) : r * (q + 1) + (xcd - r) * q) + off; }
        const int nig = WGM * nN, gid = wgid / nig, fm = gid * WGM, gsz = (nM - fm) < WGM ? (nM - fm) : WGM;
        u.pm = fm + ((wgid % nig) % gsz); u.pn = (wgid % nig) / gsz; return true;
    }
    __device__ __forceinline__ void a_ready(const Unit&) const {}
    __device__ __forceinline__ void done(const Unit&) const {}
};
__device__ __forceinline__ unsigned cvt_pk_bf16(float lo, float hi) { unsigned r; asm volatile("v_cvt_pk_bf16_f32 %0, %1, %2" : "=v"(r) : "v"(lo), "v"(hi)); return r; }
typedef float f32x2 __attribute__((ext_vector_type(2)));
typedef unsigned u32x2 __attribute__((ext_vector_type(2)));
__device__ __forceinline__ float silu_f(float g) { return g * __builtin_amdgcn_rcpf(1.0f + __builtin_amdgcn_exp2f(-g * LOG2E)); }
__device__ __forceinline__ u32x4 pack8(const f32x4 a, const f32x4 b) { u32x4 w; w.x = cvt_pk_bf16(a[0], a[1]); w.y = cvt_pk_bf16(a[2], a[3]); w.z = cvt_pk_bf16(b[0], b[1]); w.w = cvt_pk_bf16(b[2], b[3]); return w; }
struct EpiIn {
    static constexpr bool PERM = true, AFTER_DRAIN = false;
    bf16_t* proj; bf16_t* kb; bf16_t* vb; const float* rowsq; const float* rope; float* out; int att;
    template <int KIND> __device__ __forceinline__ void run(const f32x4 (&acc)[2][2][4][2], const Unit& u, int wr, int wc, int fr, int fq) const {
        const int pn = u.pn, g = 4 * (wc & 1) + fq, colb = wc * 32 + 8 * fq;
        const int rbase = u.pm * BM + wr * 64 + fr;
        float rsv[2][4];
#pragma unroll
        for (int ai = 0; ai < 2; ++ai)
#pragma unroll
            for (int m = 0; m < 4; ++m) rsv[ai][m] = rowsq[rbase + ai * HALF + m * 16];
        if (KIND == 0 || KIND == 2 || KIND == 3) {
#pragma unroll
            for (int ai = 0; ai < 2; ++ai)
#pragma unroll
                for (int m = 0; m < 4; ++m) { const int r = rbase + ai * HALF + m * 16;
                    const float rs = __builtin_amdgcn_rsqf(rsv[ai][m] * (1.0f / 1024.0f) + EPS) * (KIND == 3 ? MSCALE : 1.0f);
#pragma unroll
                    for (int bj = 0; bj < 2; ++bj) { f32x4 v0 = acc[ai][bj][m][0] * rs, v1 = acc[ai][bj][m][1] * rs;
                        if (KIND == 2) {
#pragma unroll
                            for (int i = 0; i < 4; ++i) { v0[i] = silu_f(v0[i]); v1[i] = silu_f(v1[i]); } }
                        *(u32x4*)(proj + (size_t)r * DIN + pn * BM + bj * HALF + colb) = pack8(v0, v1); } }
        } else if (KIND == 1) {
            f32x4 cs[4], sn[4]; u32x4 o0[4][2];
#pragma unroll
            for (int m = 0; m < 4; ++m) { const float* rp = rope + (size_t)((rbase + m * 16) & (SEQ - 1)) * 64 + 4 * g; cs[m] = *(const f32x4*)rp; sn[m] = *(const f32x4*)(rp + 32); }
#pragma unroll
            for (int m = 0; m < 4; ++m) { const float rs = __builtin_amdgcn_rsqf(rsv[0][m] * (1.0f / 1024.0f) + EPS) * QSCALE;
#pragma unroll
                for (int bj = 0; bj < 2; ++bj) { const f32x4 v0 = acc[0][bj][m][0] * rs, v1 = acc[0][bj][m][1] * rs; o0[m][bj] = pack8(v0 * cs[m] - v1 * sn[m], v1 * cs[m] + v0 * sn[m]); } }
            __builtin_amdgcn_sched_barrier(0);
#pragma unroll
            for (int m = 0; m < 4; ++m) { const float* rp = rope + (size_t)((rbase + HALF + m * 16) & (SEQ - 1)) * 64 + 4 * g; cs[m] = *(const f32x4*)rp; sn[m] = *(const f32x4*)(rp + 32); }
            __builtin_amdgcn_sched_barrier(0);
#pragma unroll
            for (int m = 0; m < 4; ++m)
#pragma unroll
                for (int bj = 0; bj < 2; ++bj) *(u32x4*)(proj + (size_t)(rbase + m * 16) * DIN + pn * BM + bj * HALF + colb) = o0[m][bj];
#pragma unroll
            for (int m = 0; m < 4; ++m) { const float rs = __builtin_amdgcn_rsqf(rsv[1][m] * (1.0f / 1024.0f) + EPS) * QSCALE;
#pragma unroll
                for (int bj = 0; bj < 2; ++bj) { const f32x4 v0 = acc[1][bj][m][0] * rs, v1 = acc[1][bj][m][1] * rs;
                    *(u32x4*)(proj + (size_t)(rbase + HALF + m * 16) * DIN + pn * BM + bj * HALF + colb) = pack8(v0 * cs[m] - v1 * sn[m], v1 * cs[m] + v0 * sn[m]); } }
        } else {
#pragma unroll
            for (int ai = 0; ai < 2; ++ai) {
                f32x4 cs[4], sn[4];
#pragma unroll
                for (int m = 0; m < 4; ++m) { const float* rp = rope + (size_t)((rbase + ai * HALF + m * 16) & (SEQ - 1)) * 64 + 4 * g; cs[m] = *(const f32x4*)rp; sn[m] = *(const f32x4*)(rp + 32); }
#pragma unroll
                for (int m = 0; m < 4; ++m) { const int r = rbase + ai * HALF + m * 16; const int t = r & (SEQ - 1);
                    const float rs = __builtin_amdgcn_rsqf(rsv[ai][m] * (1.0f / 1024.0f) + EPS);
                    { const f32x4 v0 = acc[ai][0][m][0] * rs, v1 = acc[ai][0][m][1] * rs; const f32x4 o0 = v0 * cs[m] - v1 * sn[m], o1 = v1 * cs[m] + v0 * sn[m];
                      *(u32x4*)(kb + (size_t)r * 128 + colb) = pack8(o0, o1);
                      if (t >= SEQ - WIN) { float* dst = out + O_WKP + ((size_t)((r >> 13) * WIN + (t - (SEQ - WIN))) * 2 + (wc >> 1)) * 64; *(f32x4*)(dst + 4 * g) = o0; *(f32x4*)(dst + 32 + 4 * g) = o1; } }
                    { const f32x4 v0 = acc[ai][1][m][0] * rs, v1 = acc[ai][1][m][1] * rs;
                      *(u32x4*)(vb + (size_t)r * 128 + colb) = pack8(v0, v1);
                      if (t >= SEQ - WIN) { float* dst = out + O_WVP + (size_t)((r >> 13) * WIN + (t - (SEQ - WIN))) * 128; *(f32x4*)(dst + colb) = v0; *(f32x4*)(dst + colb + 4) = v1; } } }
            }
        }
    }
    __device__ __forceinline__ void operator()(const f32x4 (&acc)[2][2][4][2], const Unit& u, int wr, int wc, int fr, int fq) const {
        asm volatile("" : "+v"(fr), "+v"(fq));
        const int pn = u.pn;
        if (pn < 4) { if (att) run<1>(acc, u, wr, wc, fr, fq); else run<0>(acc, u, wr, wc, fr, fq); }
        else if (pn < 8) run<2>(acc, u, wr, wc, fr, fq);
        else if (pn < 10) run<3>(acc, u, wr, wc, fr, fq);
        else if (pn < 12) run<2>(acc, u, wr, wc, fr, fq);
        else run<4>(acc, u, wr, wc, fr, fq);
    }
};
struct EpiOut {
    static constexpr bool PERM = true, AFTER_DRAIN = false;
    float* xf; bf16_t* xb; float* rowsq_next;
    __device__ __forceinline__ void operator()(const f32x4 (&acc)[2][2][4][2], const Unit& u, int wr, int wc, int fr, int fq) const {
        asm volatile("" : "+v"(fr), "+v"(fq));
        const int col0 = u.pn * BM + wc * 32 + 8 * fq, rbase = u.pm * BM + wr * 64 + fr;
        u32x4 xo[2][4][2];
#pragma unroll
        for (int ai = 0; ai < 2; ++ai)
#pragma unroll
            for (int m = 0; m < 4; ++m)
#pragma unroll
                for (int bj = 0; bj < 2; ++bj) xo[ai][m][bj] = *(const u32x4*)(xb + (size_t)(rbase + ai * HALF + m * 16) * DM + col0 + bj * HALF);
#pragma unroll
        for (int ai = 0; ai < 2; ++ai)
#pragma unroll
            for (int m = 0; m < 4; ++m) { const int r = rbase + ai * HALF + m * 16; float ss = 0.f;
#pragma unroll
                for (int bj = 0; bj < 2; ++bj) { const u32x4 wo = xo[ai][m][bj];
                    const f32x4 x0 = (f32x4){__builtin_bit_cast(float, wo.x << 16), __builtin_bit_cast(float, wo.x & 0xffff0000u), __builtin_bit_cast(float, wo.y << 16), __builtin_bit_cast(float, wo.y & 0xffff0000u)} + acc[ai][bj][m][0];
                    const f32x4 x1 = (f32x4){__builtin_bit_cast(float, wo.z << 16), __builtin_bit_cast(float, wo.z & 0xffff0000u), __builtin_bit_cast(float, wo.w << 16), __builtin_bit_cast(float, wo.w & 0xffff0000u)} + acc[ai][bj][m][1];
                    *(u32x4*)(xb + (size_t)r * DM + col0 + bj * HALF) = pack8(x0, x1);
                    ss += ((x0[0] * x0[0] + x0[1] * x0[1]) + (x0[2] * x0[2] + x0[3] * x0[3])) + ((x1[0] * x1[0] + x1[1] * x1[1]) + (x1[2] * x1[2] + x1[3] * x1[3])); }
                ss += __shfl_xor(ss, 16); ss += __shfl_xor(ss, 32);
                if (fq == 0) atomicAdd(rowsq_next + r, ss);
            }
    }
};
struct EpiOutFinal {
    static constexpr bool PERM = true, AFTER_DRAIN = true;
    float* y; const bf16_t* xb; const float* gfin; float* slots; unsigned* cnt;
    __device__ __forceinline__ void fused(f32x4 (&acc)[2][2][4][2], const Unit& u, int wr, int wc, int fr, int fq, PG8_LAS unsigned char* lds, int wid, int lane) const {
        asm volatile("" : "+v"(fr), "+v"(fq));
        PG8_LAS float* P = (PG8_LAS float*)lds;
        PG8_LAS float* S = (PG8_LAS float*)(lds + 4096);
        const int col0 = u.pn * BM + wc * 32 + 8 * fq, rbase = u.pm * BM + wr * 64 + fr;
        u32x4 xo[2][4][2];
#pragma unroll
        for (int ai = 0; ai < 2; ++ai)
#pragma unroll
            for (int m = 0; m < 4; ++m)
#pragma unroll
                for (int bj = 0; bj < 2; ++bj) xo[ai][m][bj] = *(const u32x4*)(xb + (size_t)(rbase + ai * HALF + m * 16) * DM + col0 + bj * HALF);
#pragma unroll
        for (int ai = 0; ai < 2; ++ai)
#pragma unroll
            for (int m = 0; m < 4; ++m) { float ss = 0.f;
#pragma unroll
                for (int bj = 0; bj < 2; ++bj) { const u32x4 wo = xo[ai][m][bj];
                    const f32x4 x0 = (f32x4){__builtin_bit_cast(float, wo.x << 16), __builtin_bit_cast(float, wo.x & 0xffff0000u), __builtin_bit_cast(float, wo.y << 16), __builtin_bit_cast(float, wo.y & 0xffff0000u)} + acc[ai][bj][m][0];
                    const f32x4 x1 = (f32x4){__builtin_bit_cast(float, wo.z << 16), __builtin_bit_cast(float, wo.z & 0xffff0000u), __builtin_bit_cast(float, wo.w << 16), __builtin_bit_cast(float, wo.w & 0xffff0000u)} + acc[ai][bj][m][1];
                    acc[ai][bj][m][0] = x0; acc[ai][bj][m][1] = x1;
                    ss += ((x0[0] * x0[0] + x0[1] * x0[1]) + (x0[2] * x0[2] + x0[3] * x0[3])) + ((x1[0] * x1[0] + x1[1] * x1[1]) + (x1[2] * x1[2] + x1[3] * x1[3])); }
                ss += __shfl_xor(ss, 16); ss += __shfl_xor(ss, 32);
                if (fq == 0) P[(ai * HALF + wr * 64 + m * 16 + fr) * 4 + wc] = ss; }
        asm volatile("s_waitcnt lgkmcnt(0)" ::: "memory"); __builtin_amdgcn_s_barrier(); asm volatile("" ::: "memory");
        const int tid = wid * 64 + lane;
        if (tid < 256) {
            const float s = (P[tid * 4 + 0] + P[tid * 4 + 1]) + (P[tid * 4 + 2] + P[tid * 4 + 3]);
            __hip_atomic_store((unsigned*)slots + (size_t)(u.pm * BM + tid) * 4 + u.pn, __builtin_bit_cast(unsigned, s), __ATOMIC_RELAXED, __HIP_MEMORY_SCOPE_AGENT);
            asm volatile("s_waitcnt vmcnt(0)" ::: "memory");
            if (lane == 0) __hip_atomic_fetch_add(cnt + 64 * u.pm, 1u, __ATOMIC_RELAXED, __HIP_MEMORY_SCOPE_AGENT);
        }
        if (wid == 0) {
            unsigned spins = 0;
            while ((unsigned)__builtin_amdgcn_readfirstlane(__hip_atomic_load(cnt + 64 * u.pm, __ATOMIC_RELAXED, __HIP_MEMORY_SCOPE_AGENT)) < 16u && ++spins < (1u << 22)) __builtin_amdgcn_s_sleep(2);
            __builtin_amdgcn_fence(__ATOMIC_ACQUIRE, "agent");
        }
        asm volatile("s_waitcnt vmcnt(0) lgkmcnt(0)" ::: "memory"); __builtin_amdgcn_s_barrier(); asm volatile("" ::: "memory");
        f32x4 gv[2][2];
#pragma unroll
        for (int bj = 0; bj < 2; ++bj)
#pragma unroll
            for (int n = 0; n < 2; ++n) gv[bj][n] = *(const f32x4*)(gfin + col0 + bj * HALF + n * 4);
        if (tid < 256) { const unsigned* sl = (const unsigned*)slots + (size_t)(u.pm * BM + tid) * 4; float t = 0.f;
#pragma unroll
            for (int k = 0; k < 4; ++k) t += __builtin_bit_cast(float, __hip_atomic_load(sl + k, __ATOMIC_RELAXED, __HIP_MEMORY_SCOPE_AGENT));
            S[tid] = 1.0f / sqrtf(t * (1.0f / 1024.0f) + EPS); }
        asm volatile("s_waitcnt vmcnt(0) lgkmcnt(0)" ::: "memory"); __builtin_amdgcn_s_barrier(); asm volatile("" ::: "memory");
#pragma unroll
        for (int ai = 0; ai < 2; ++ai)
#pragma unroll
            for (int m = 0; m < 4; ++m) { const float rs = S[ai * HALF + wr * 64 + m * 16 + fr]; float* yr = y + (size_t)(rbase + ai * HALF + m * 16) * DM + col0;
#pragma unroll
                for (int bj = 0; bj < 2; ++bj)
#pragma unroll
                    for (int n = 0; n < 2; ++n) __builtin_nontemporal_store(acc[ai][bj][m][n] * rs * gv[bj][n], (f32x4*)(yr + bj * HALF + n * 4)); }
    }
};
struct EpiMem {
    static constexpr bool PERM = false, AFTER_DRAIN = false;
    float* omk0; float* omv0; bf16_t* mkb0; bf16_t* mvb0; const float* rowsq;
    __device__ __forceinline__ void operator()(const f32x4 (&acc)[2][2][4][2], const Unit& u, int wr, int wc, int fr, int fq) const {
        asm volatile("" : "+v"(fr), "+v"(fq));
        const int lay = u.pn >> 2; const size_t lo_ = (size_t)lay * 512 * 512;
        float* omk = omk0 + lo_; float* omv = omv0 + lo_; bf16_t* mkb = mkb0 + lo_; bf16_t* mvb = mvb0 + lo_;
        const int col0 = (u.pn & 3) * BM + wc * 32 + 4 * fq;
        float rsv[2][4];
#pragma unroll
        for (int ai = 0; ai < 2; ++ai)
#pragma unroll
            for (int m = 0; m < 4; ++m) rsv[ai][m] = rowsq[u.pm * BM + ai * HALF + wr * 64 + m * 16 + fr];
#pragma unroll
        for (int ai = 0; ai < 2; ++ai)
#pragma unroll
            for (int m = 0; m < 4; ++m) {
                const int r = u.pm * BM + ai * HALF + wr * 64 + m * 16 + fr;
                const float rs = __builtin_amdgcn_rsqf(rsv[ai][m] * (1.0f / 1024.0f) + EPS);
#pragma unroll
                for (int bj = 0; bj < 2; ++bj)
#pragma unroll
                    for (int n = 0; n < 2; ++n) { const int c = col0 + bj * HALF + n * 16; const f32x4 v = acc[ai][bj][m][n] * rs;
                        u32x2 w; w.x = cvt_pk_bf16(v[0], v[1]); w.y = cvt_pk_bf16(v[2], v[3]);
                        if (c < DMEMW) { __builtin_nontemporal_store(v, (f32x4*)(omk + (size_t)r * DMEMW + c)); *(u32x2*)(mkb + (size_t)r * DMEMW + c) = w; }
                        else { __builtin_nontemporal_store(v, (f32x4*)(omv + (size_t)r * DMEMW + c - DMEMW)); *(u32x2*)(mvb + (size_t)r * DMEMW + c - DMEMW) = w; } }
            }
    }
};
template <class Epi, class Sched, bool ALIGN_EPI = false, bool SP2 = false>
__device__ __forceinline__ void gemm_phase(PG8_LAS unsigned char* lds, const Gemm g, const Sched& S, const Epi& E) {
    int tid_ = threadIdx.x; asm volatile("" : "+v"(tid_));
    const int tid = tid_, wid = __builtin_amdgcn_readfirstlane(tid >> 6), lane = tid & 63, wr = wid >> 2, wc = wid & 3, fr = lane & 15, fq = lane >> 4;
    const int K = g.K, nt = K / BK;
    unsigned voffA[2], voffB[2];
#pragma unroll
    for (int i = 0; i < 2; ++i) { int R, C; stage_rc(tid * 16 + i * 8192, R, C); const int Rb = Epi::PERM ? ((R & ~31) + perm32(R & 31)) : R;
        voffA[i] = (unsigned)(R * K + C) * 2u; voffB[i] = (unsigned)(Rb * K + C) * 2u; }
    const size_t kstep = (size_t)(BK * 2);
    const size_t hstep = (size_t)HALF * K * 2;
    const size_t tstep = 2 * hstep;
    const unsigned ldsw = (unsigned)wid * 1024u;
    const int aoff = lds_byte(wr * 64 + fr, fq * 8), boff = lds_byte(wc * 32 + fr, fq * 8);
#define PG8_SA(b, h) (((b) * 2 + (h)) * HTB)
#define PG8_SB(b, h) ((4 + (b) * 2 + (h)) * HTB)
#define PG8_STAGE(bufoff, gbase, voff) do { _Pragma("unroll") for (int _i = 0; _i < 2; ++_i) \
        __builtin_amdgcn_global_load_lds((const unsigned*)((const char*)(gbase) + (voff)[_i]), (PG8_LAS unsigned*)(lds + (bufoff) + ldsw + _i * 8192), 16, 0, 0); } while (0)
#define PG8_LDA(dst, b, h) do { _Pragma("unroll") for (int m = 0; m < 4; ++m) _Pragma("unroll") for (int k = 0; k < 2; ++k) dst[m][k] = *(const PG8_LAS bf16x8*)(lds + PG8_SA(b, h) + aoff + m * 2048 + k * 1024); } while (0)
#define PG8_LDB(dst, b, h) do { _Pragma("unroll") for (int n = 0; n < 2; ++n) _Pragma("unroll") for (int k = 0; k < 2; ++k) dst[n][k] = *(const PG8_LAS bf16x8*)(lds + PG8_SB(b, h) + boff + n * 2048 + k * 1024); } while (0)
#define PG8_MMA(ai, bj, At, Bt) do { __builtin_amdgcn_s_setprio(1); _Pragma("unroll") for (int m = 0; m < 4; ++m) _Pragma("unroll") for (int n = 0; n < 2; ++n) _Pragma("unroll") for (int k = 0; k < 2; ++k) \
        acc[ai][bj][m][n] = __builtin_amdgcn_mfma_f32_16x16x32_bf16(Bt[n][k], At[m][k], acc[ai][bj][m][n], 0, 0, 0); __builtin_amdgcn_s_setprio(0); } while (0)
#define PG8_WAIT_V(n) asm volatile("s_waitcnt vmcnt(" #n ")" ::: "memory")
#define PG8_WAIT_L(n) asm volatile("s_waitcnt lgkmcnt(" #n ")" ::: "memory")
#define PG8_BAR __builtin_amdgcn_s_barrier()
#define PG8_SCHED __builtin_amdgcn_sched_barrier(0)
    Unit cur, nxt; int ui = 0;
    if (!S.next(0, cur)) return;
    f32x4 acc[2][2][4][2];
#pragma unroll
    for (int a = 0; a < 2; ++a)
#pragma unroll
        for (int b = 0; b < 2; ++b)
#pragma unroll
            for (int m = 0; m < 4; ++m)
#pragma unroll
                for (int n = 0; n < 2; ++n) acc[a][b][m][n] = (f32x4){0.f, 0.f, 0.f, 0.f};
    bf16x8 At[4][2], B0[2][2], B1[2][2];
    const char* cA = (const char*)g.A + (size_t)cur.pm * tstep; const char* cB = (const char*)g.Bt + (size_t)cur.pn * tstep;
    S.a_ready(cur);
    if constexpr (SP2) {
        PG8_STAGE(PG8_SB(0, 0), cB, voffB); PG8_STAGE(PG8_SB(0, 1), cB + hstep, voffB); PG8_STAGE(PG8_SA(0, 0), cA, voffA); PG8_STAGE(PG8_SA(0, 1), cA + hstep, voffA);
        if (wr == 1) PG8_BAR;
        PG8_WAIT_V(2); PG8_BAR;
        PG8_STAGE(PG8_SB(1, 0), cB + kstep, voffB); PG8_STAGE(PG8_SA(1, 0), cA + kstep, voffA); PG8_STAGE(PG8_SB(1, 1), cB + hstep + kstep, voffB);
        PG8_WAIT_V(6); PG8_BAR;
    } else {
        PG8_STAGE(PG8_SB(0, 0), cB, voffB); PG8_STAGE(PG8_SA(0, 0), cA, voffA); PG8_STAGE(PG8_SB(0, 1), cB + hstep, voffB); PG8_STAGE(PG8_SA(0, 1), cA + hstep, voffA);
        if (wr == 1) PG8_BAR;
        PG8_WAIT_V(4); PG8_BAR;
        PG8_STAGE(PG8_SB(1, 0), cB + kstep, voffB); PG8_STAGE(PG8_SA(1, 0), cA + kstep, voffA); PG8_STAGE(PG8_SB(1, 1), cB + hstep + kstep, voffB);
        PG8_WAIT_V(6); PG8_BAR;
    }
    for (;;) {
        const bool has_next = S.next(ui + 1, nxt);
        const char* nA = has_next ? (const char*)g.A + (size_t)nxt.pm * tstep : cA; const char* nB = has_next ? (const char*)g.Bt + (size_t)nxt.pn * tstep : cB;
        for (int t = 0; t < nt; t += 2) {
            const bool last = (t == nt - 2);
            const char* a1 = cA + (size_t)(t + 1) * kstep;
            const char* a2 = last ? nA : cA + (size_t)(t + 2) * kstep; const char* b2 = last ? nB : cB + (size_t)(t + 2) * kstep;
            const char* a3 = a2 + kstep; const char* b3 = b2 + kstep;
            if (last && has_next) S.a_ready(nxt);
            if constexpr (SP2) {
            PG8_LDB(B0, 0, 0); PG8_LDB(B1, 0, 1); PG8_SCHED; PG8_LDA(At, 0, 0); PG8_STAGE(PG8_SA(1, 1), a1 + hstep, voffA);
            PG8_WAIT_V(8); PG8_WAIT_L(0); PG8_BAR; PG8_MMA(0, 0, At, B0); PG8_MMA(0, 1, At, B1); PG8_BAR; PG8_SCHED;
            PG8_LDA(At, 0, 1); PG8_STAGE(PG8_SB(0, 0), b2, voffB); PG8_STAGE(PG8_SB(0, 1), b2 + hstep, voffB); PG8_STAGE(PG8_SA(0, 0), a2, voffA);
            PG8_WAIT_V(8); PG8_WAIT_L(0); PG8_BAR; PG8_MMA(1, 0, At, B0); PG8_MMA(1, 1, At, B1); PG8_BAR; PG8_SCHED;
            PG8_LDB(B0, 1, 0); PG8_LDB(B1, 1, 1); PG8_SCHED; PG8_LDA(At, 1, 0); PG8_STAGE(PG8_SA(0, 1), a2 + hstep, voffA);
            PG8_WAIT_V(8); PG8_WAIT_L(0); PG8_BAR; PG8_MMA(0, 0, At, B0); PG8_MMA(0, 1, At, B1); PG8_BAR; PG8_SCHED;
            PG8_LDA(At, 1, 1); PG8_STAGE(PG8_SB(1, 0), b3, voffB); PG8_STAGE(PG8_SB(1, 1), b3 + hstep, voffB); PG8_STAGE(PG8_SA(1, 0), a3, voffA);
            PG8_WAIT_V(8); PG8_WAIT_L(0); PG8_BAR; PG8_MMA(1, 0, At, B0); PG8_MMA(1, 1, At, B1); PG8_BAR; PG8_SCHED;
            } else {
            PG8_LDB(B0, 0, 0); PG8_SCHED; PG8_LDA(At, 0, 0); PG8_STAGE(PG8_SA(1, 1), a1 + hstep, voffA);
            PG8_WAIT_L(8); PG8_BAR; PG8_WAIT_L(0); PG8_MMA(0, 0, At, B0); PG8_BAR; PG8_SCHED;
            PG8_LDB(B1, 0, 1); PG8_STAGE(PG8_SB(0, 0), b2, voffB);
            PG8_BAR; PG8_WAIT_L(0); PG8_MMA(0, 1, At, B1); PG8_BAR;
            PG8_LDA(At, 0, 1); PG8_STAGE(PG8_SA(0, 0), a2, voffA);
            PG8_BAR; PG8_WAIT_L(0); PG8_MMA(1, 0, At, B0); PG8_BAR; PG8_SCHED;
            PG8_STAGE(PG8_SB(0, 1), b2 + hstep, voffB);
            PG8_WAIT_V(6); PG8_BAR; PG8_MMA(1, 1, At, B1); PG8_BAR;
            PG8_LDB(B0, 1, 0); PG8_SCHED; PG8_LDA(At, 1, 0); PG8_STAGE(PG8_SA(0, 1), a2 + hstep, voffA);
            PG8_WAIT_L(8); PG8_BAR; PG8_WAIT_L(0); PG8_MMA(0, 0, At, B0); PG8_BAR; PG8_SCHED;
            PG8_LDB(B1, 1, 1); PG8_STAGE(PG8_SB(1, 0), b3, voffB);
            PG8_BAR; PG8_WAIT_L(0); PG8_MMA(0, 1, At, B1); PG8_BAR;
            PG8_LDA(At, 1, 1); PG8_STAGE(PG8_SA(1, 0), a3, voffA);
            PG8_BAR; PG8_WAIT_L(0); PG8_MMA(1, 0, At, B0); PG8_BAR; PG8_SCHED;
            PG8_STAGE(PG8_SB(1, 1), b3 + hstep, voffB);
            PG8_WAIT_V(6); PG8_BAR; PG8_MMA(1, 1, At, B1); PG8_BAR;
            }
        }
        if constexpr (ALIGN_EPI) { if (wr == 0) PG8_BAR; }
        if constexpr (!Epi::AFTER_DRAIN) { E(acc, cur, wr, wc, fr, fq); S.done(cur); }
        if (!has_next) break;
#pragma unroll
        for (int a = 0; a < 2; ++a)
#pragma unroll
            for (int b = 0; b < 2; ++b)
#pragma unroll
                for (int m = 0; m < 4; ++m)
#pragma unroll
                    for (int n = 0; n < 2; ++n) acc[a][b][m][n] = (f32x4){0.f, 0.f, 0.f, 0.f};
        cur = nxt; cA = nA; cB = nB; ++ui;
        if constexpr (ALIGN_EPI) { if (wr == 1) PG8_BAR; }
    }
    PG8_WAIT_V(0);
    if constexpr (!ALIGN_EPI) { if (wr == 0) PG8_BAR; }
    PG8_BAR;
    if constexpr (Epi::AFTER_DRAIN) { E.fused(acc, cur, wr, wc, fr, fq, lds, wid, lane); S.done(cur); }
#undef PG8_SA
#undef PG8_SB
#undef PG8_STAGE
#undef PG8_LDA
#undef PG8_LDB
#undef PG8_MMA
#undef PG8_WAIT_V
#undef PG8_WAIT_L
#undef PG8_BAR
#undef PG8_SCHED
}
}
constexpr size_t MiB = 1u << 20;
constexpr size_t WS_CTL = 0, CTL_ZERO_BYTES = 2 * MiB;
constexpr size_t WS_ROWSQ = 1 * MiB;
constexpr size_t WS_WIN = 2 * MiB, WIN_STRIDE = 7 * MiB;
constexpr size_t WS_WOUT = 30 * MiB, WOUT_STRIDE = 3 * MiB;
constexpr size_t WS_WMEM = 42 * MiB, WMEM_STRIDE = 2 * MiB;
constexpr size_t WS_WG = 50 * MiB;
constexpr size_t WS_ROPE = 51 * MiB;
constexpr size_t WS_XB = 54 * MiB;
constexpr size_t WS_MEMB = 87 * MiB, WS_RSQM = 88 * MiB;
constexpr size_t WS_PROJ = 90 * MiB;
constexpr size_t WS_KB = 188 * MiB, WS_VB = 193 * MiB;
constexpr size_t WS_Z = 198 * MiB;
constexpr size_t WS_MKB = 247 * MiB, WS_MVB = 249 * MiB;
constexpr size_t WS_AGG = 251 * MiB;
constexpr size_t WS_XCHG = 253 * MiB;
constexpr size_t WS_LAB = 256 * MiB, WS_END = 384 * MiB;
constexpr int CW_BAR = 4096;
constexpr int CW_FIN = 458752;
constexpr int CW_LRUF = 393216;

constexpr int RING_OFF = 0, RING_BYTES = 131072;
constexpr int LDS_BYTES = 163840;
constexpr int LDSCTL_OFF = LDS_BYTES - 1024, MISC_OFF = LDSCTL_OFF + 320;
constexpr int NWAVES = 8;

#define GAS __attribute__((address_space(1)))
#define LAS __attribute__((address_space(3)))
typedef unsigned short bf16;
typedef unsigned v4u __attribute__((ext_vector_type(4)));
typedef float f32x4 __attribute__((ext_vector_type(4)));
typedef GAS unsigned gu32;
#define RLX_AGENT __ATOMIC_RELAXED, __HIP_MEMORY_SCOPE_AGENT
#define LDS_WAIT() asm volatile("s_waitcnt lgkmcnt(0)" ::: "memory")
#define VM_WAIT() asm volatile("s_waitcnt vmcnt(0)" ::: "memory")
__device__ __forceinline__ unsigned f2bf(float f) { unsigned u = __builtin_bit_cast(unsigned, f); return (u + 0x7fffu + ((u >> 16) & 1u)) >> 16; }
__device__ __forceinline__ unsigned pk2(float lo, float hi) { return f2bf(lo) | (f2bf(hi) << 16); }
__device__ __forceinline__ float bf2f(bf16 h) { return __builtin_bit_cast(float, (unsigned)h << 16); }
__device__ __forceinline__ float wave_sum(float v) {
#pragma unroll
    for (int o = 1; o < 64; o <<= 1) v += __shfl_xor(v, o);
    return v;
}
__device__ __forceinline__ float wave_max(float v) {
#pragma unroll
    for (int o = 1; o < 64; o <<= 1) v = fmaxf(v, __shfl_xor(v, o));
    return v;
}
__device__ const float INVF[32] = {1.000000000e+00f, 7.498942614e-01f, 5.623413324e-01f, 4.216965139e-01f, 3.162277639e-01f, 2.371373773e-01f, 1.778279394e-01f, 1.333521307e-01f,
    1.000000015e-01f, 7.498941571e-02f, 5.623413250e-02f, 4.216965288e-02f, 3.162277490e-02f, 2.371373773e-02f, 1.778279431e-02f, 1.333521493e-02f,
    9.999999776e-03f, 7.498941850e-03f, 5.623413250e-03f, 4.216964822e-03f, 3.162277630e-03f, 2.371373586e-03f, 1.778279431e-03f, 1.333521446e-03f,
    1.000000047e-03f, 7.498942432e-04f, 5.623413017e-04f, 4.216965172e-04f, 3.162277571e-04f, 2.371373703e-04f, 1.778279402e-04f, 1.333521504e-04f};
#define XB_TMO      128
#define XB_XCNT(j)  (256  + 64 * (j))
#define XB_XSUB(j)  (1280 + 64 * (j))
#define XB_XGEN(j)  (2304 + 64 * (j))
#define XB_TOP      3328
#define XB_TOPGEN   3392
#define XCD_BAR_WORDS 3456
#define XB_SPIN_CAP (1u << 18)

__device__ __forceinline__ unsigned xb_ld(unsigned* p)              { return __hip_atomic_load(p, __ATOMIC_RELAXED, __HIP_MEMORY_SCOPE_AGENT); }
__device__ __forceinline__ unsigned xb_add(unsigned* p, unsigned v) { return __hip_atomic_fetch_add(p, v, __ATOMIC_RELAXED, __HIP_MEMORY_SCOPE_AGENT); }
__device__ __forceinline__ unsigned xb_xcc_id() { return (unsigned)__builtin_amdgcn_s_getreg((3 << 11) | 20) & 0xFu; }
#define XB_SPIN(cond, bar) do { unsigned _sp = 0; while (cond) { __builtin_amdgcn_s_sleep(1); \
    if ((++_sp & 255u) == 0u) { if (xb_ld(&(bar)[XB_TMO])) break; if (_sp > XB_SPIN_CAP) { atomicAdd(&(bar)[XB_TMO], 1u); break; } } } } while (0)

struct XcdBarrier {
    unsigned* bar; unsigned x;
    volatile LAS unsigned* st;
};

__device__ __forceinline__ XcdBarrier xcd_barrier_post(unsigned* bar, volatile LAS unsigned* st) {
    XcdBarrier b; b.bar = bar; b.x = xb_xcc_id(); b.st = st;
    if (threadIdx.x == 0) (void)xb_add(&bar[XB_XCNT(b.x)], 1u);
    return b;
}
__device__ __forceinline__ void xcd_barrier_complete(unsigned* bar, unsigned x, unsigned& nloc, unsigned& nx) {
    const unsigned G = gridDim.x * gridDim.y * gridDim.z;
    unsigned sum, cnt, mine, sp = 0u;
    for (;;) {
        sum = 0u; cnt = 0u; mine = 0u;
#pragma unroll
        for (unsigned j = 0; j < 16; ++j) { const unsigned c = xb_ld(&bar[XB_XCNT(j)]); sum += c; cnt += (c > 0u) ? 1u : 0u; mine = (j == x) ? c : mine; }
        if (sum == G) break;
        __builtin_amdgcn_s_sleep(1);
        if ((++sp & 255u) == 0u) { if (xb_ld(&bar[XB_TMO])) break; if (sp > XB_SPIN_CAP) { atomicAdd(&bar[XB_TMO], 1u); break; } }
    }
    nloc = mine > 0u ? mine : 1u; nx = cnt > 0u ? cnt : 1u;
}

__device__ __forceinline__ void xcd_barrier(const XcdBarrier& b) {
    asm volatile("s_waitcnt vmcnt(0)" ::: "memory");
    __syncthreads();
    if (threadIdx.x == 0) {
        unsigned* bar = b.bar;
        __builtin_amdgcn_s_waitcnt(0);
        unsigned nloc = b.st[0], nx = b.st[1];
        if (nloc == 0u) { xcd_barrier_complete(bar, b.x, nloc, nx); b.st[0] = nloc; b.st[1] = nx; }
        const unsigned old = xb_add(&bar[XB_XSUB(b.x)], 1u);
        const unsigned gen = old / nloc;
        if (old + 1u == (gen + 1u) * nloc) {
            __builtin_amdgcn_fence(__ATOMIC_RELEASE, "agent");
            asm volatile("s_waitcnt vmcnt(0)" ::: "memory");
            const unsigned og = xb_add(&bar[XB_TOP], 1u);
            const unsigned tg = og / nx;
            if (og + 1u == (tg + 1u) * nx) xb_add(&bar[XB_TOPGEN], 1u);
            else XB_SPIN(xb_ld(&bar[XB_TOPGEN]) == tg, bar);
            __builtin_amdgcn_fence(__ATOMIC_ACQUIRE, "agent");
            xb_add(&bar[XB_XGEN(b.x)], 1u);
            asm volatile("s_waitcnt vmcnt(0)" ::: "memory");
        } else {
            XB_SPIN(xb_ld(&bar[XB_XGEN(b.x)]) == gen, bar);
            __builtin_amdgcn_fence(__ATOMIC_ACQUIRE, "agent");
            asm volatile("s_waitcnt vmcnt(0)" ::: "memory");
        }
    }
    __syncthreads();
}
enum { I_XP = 0, I_XS, I_CMK, I_CMV, I_STH, I_STC, I_CWK, I_CWV, I_MEMP, I_NORMG, I_WIN, I_WOUT, I_MEMNG, I_WMEMKV, I_CONVW, I_CONVB, I_WA, I_BA, I_WX, I_BX, I_LAM, I_KVNG, I_WKV, I_SINKS, I_FINALG, N_IN };
struct Args { const float* in[N_IN]; float* out; unsigned char* ws; int ph_lo, ph_hi; };

typedef const __attribute__((address_space(4))) Args* ArgsP;
__device__ __forceinline__ ArgsP get_args() { ArgsP p = (ArgsP)__builtin_amdgcn_kernarg_segment_ptr(); asm volatile("" : "+s"(p)); return p; }
struct Ids { int tid, lane, wave, gw, NGW, gtid, GT; };
__device__ __forceinline__ Ids make_ids() {
    Ids I; int tid = threadIdx.x; asm volatile("" : "+v"(tid));
    I.tid = tid; I.lane = tid & 63; I.wave = __builtin_amdgcn_readfirstlane(tid >> 6);
    int G = gridDim.x, bx = blockIdx.x; asm volatile("" : "+s"(G), "+s"(bx));
    const int vcu = (G % 8 == 0) ? (bx % 8) * (G / 8) + bx / 8 : bx;
    I.gw = vcu * 8 + I.wave; I.NGW = G * 8; I.gtid = vcu * 512 + tid; I.GT = G * 512; return I;
}

__device__ __forceinline__ int permpos(int d) { return d < 32 ? 8 * (d >> 2) + (d & 3) : 8 * ((d - 32) >> 2) + 4 + (d & 3); }
__device__ __forceinline__ int permdim(int p) { return 32 * ((p >> 2) & 1) + 4 * (p >> 3) + (p & 3); }
__device__ __forceinline__ void p0_transpose_item(const float* W, int K, int N, const float* gs, bf16* WT, int row_off, int perm_cols, LAS float* scr, int item, int lane) {
    const int nblk = N / 32, kb = item / nblk, nb = item % nblk, k0 = 64 * kb, n0 = 32 * nb;
    f32x4 wv[8]; float gv[8];
#pragma unroll
    for (int i = 0; i < 8; ++i) { const int kk = (lane >> 3) + 8 * i; wv[i] = *(const f32x4*)(W + (size_t)(k0 + kk) * N + n0 + 4 * (lane & 7)); gv[i] = gs ? gs[k0 + kk] : 1.0f; }
    __builtin_amdgcn_sched_barrier(0);
#pragma unroll
    for (int i = 0; i < 8; ++i) { const int kk = (lane >> 3) + 8 * i; LAS float* d = scr + kk * 33 + 4 * (lane & 7);
        d[0] = wv[i][0] * gv[i]; d[1] = wv[i][1] * gv[i]; d[2] = wv[i][2] * gv[i]; d[3] = wv[i][3] * gv[i]; }
    LDS_WAIT(); asm volatile("" ::: "memory");
    const int c = lane & 7;
#pragma unroll
    for (int j = 0; j < 4; ++j) { const int n = (lane >> 3) + 8 * j; const LAS float* s = scr + (8 * c) * 33 + n;
        v4u o; o.x = pk2(s[0 * 33], s[1 * 33]); o.y = pk2(s[2 * 33], s[3 * 33]); o.z = pk2(s[4 * 33], s[5 * 33]); o.w = pk2(s[6 * 33], s[7 * 33]);
        const int nn = n0 + n; const int row = nn < perm_cols ? (nn & ~63) + permpos(nn & 63) : nn;
        *(GAS v4u*)(WT + (size_t)(row_off + row) * K + k0 + 8 * c) = o; }
    LDS_WAIT(); asm volatile("" ::: "memory");
}
__device__ __forceinline__ void row_to_bf16(const float* xrow, bf16* orow, float* sq, int lane) {
    const GAS f32x4* xr = (const GAS f32x4*)xrow + lane;
    f32x4 v[4]; float s = 0.f;
#pragma unroll
    for (int j = 0; j < 4; ++j) { v[j] = xr[64 * j]; s += (v[j].x * v[j].x + v[j].y * v[j].y) + (v[j].z * v[j].z + v[j].w * v[j].w); }
    s = wave_sum(s);
    GAS unsigned long long* o8 = (GAS unsigned long long*)orow + lane;
#pragma unroll
    for (int j = 0; j < 4; ++j) o8[64 * j] = (unsigned long long)pk2(v[j].x, v[j].y) | ((unsigned long long)pk2(v[j].z, v[j].w) << 32);
    if (lane == 0) *sq = s;
}
__device__ __forceinline__ void sincos_f32arg(float angf, float& c, float& s) {
    const double x = (double)angf;
    const double kq = __builtin_rint(x * 0.63661977236758134308);
    double r = __builtin_fma(-kq, 1.57079632679489655800e+00, x); r = __builtin_fma(-kq, 6.12323399573676603587e-17, r);
    const double r2 = r * r;
    double sp = 1.0 / 6227020800.0; sp = sp * r2 - 1.0 / 39916800.0; sp = sp * r2 + 1.0 / 362880.0; sp = sp * r2 - 1.0 / 5040.0; sp = sp * r2 + 1.0 / 120.0; sp = sp * r2 - 1.0 / 6.0; sp = sp * r2 + 1.0; sp = sp * r;
    double cp = -1.0 / 87178291200.0; cp = cp * r2 + 1.0 / 479001600.0; cp = cp * r2 - 1.0 / 3628800.0; cp = cp * r2 + 1.0 / 40320.0; cp = cp * r2 - 1.0 / 720.0; cp = cp * r2 + 1.0 / 24.0; cp = cp * r2 - 0.5; cp = cp * r2 + 1.0;
    const int q = ((int)kq) & 3;
    const double cc = (q == 0) ? cp : (q == 1) ? -sp : (q == 2) ? -cp : sp;
    const double ss = (q == 0) ? sp : (q == 1) ? cp : (q == 2) ? -sp : -cp;
    c = (float)cc; s = (float)ss;
}
struct WJob { const float* W; const float* gs; bf16* WT; int K, N, row_off, perm_cols; };
__device__ __forceinline__ void wtile_fetch(float (&v)[32], const WJob& J, int tile, int tid) {
    const int ntn = J.N >> 8, kb = tile / ntn, nb = tile - kb * ntn;
#pragma unroll
    for (int i = 0; i < 32; ++i) { const int idx = tid + 512 * i, row = idx >> 8, col = idx & 255; v[i] = __builtin_nontemporal_load(&J.W[(size_t)(64 * kb + row) * J.N + 256 * nb + col]); }
}
__device__ __forceinline__ void wtile_put(const float (&v)[32], const WJob& J, int tile, int tid, LAS float* scr) {
    const int ntn = J.N >> 8, kb = tile / ntn;
#pragma unroll
    for (int i = 0; i < 32; ++i) { const int idx = tid + 512 * i, row = idx >> 8, col = idx & 255; scr[row * 257 + col] = v[i] * (J.gs ? J.gs[64 * kb + row] : 1.0f); }
}
__device__ __forceinline__ void wtile_store(const WJob& J, int tile, int tid, const LAS float* scr) {
    const int ntn = J.N >> 8, kb = tile / ntn, nb = tile - kb * ntn, c = tid & 7;
#pragma unroll
    for (int j = 0; j < 4; ++j) { const int n = (tid >> 3) + 64 * j; const LAS float* sp = scr + (8 * c) * 257 + n;
        v4u o; o.x = pk2(sp[0 * 257], sp[1 * 257]); o.y = pk2(sp[2 * 257], sp[3 * 257]); o.z = pk2(sp[4 * 257], sp[5 * 257]); o.w = pk2(sp[6 * 257], sp[7 * 257]);
        const int nn = 256 * nb + n; const int row = nn < J.perm_cols ? (nn & ~63) + permpos(nn & 63) : nn;
        *(GAS v4u*)(J.WT + (size_t)(J.row_off + row) * J.K + 64 * kb + 8 * c) = o; }
}
__device__ __forceinline__ WJob wjob(ArgsP A, int kind, int l) {
    unsigned char* ws = A->ws; WJob J;
    if (kind == 0) { J.W = A->in[I_WIN] + (size_t)l * DM * DIN; J.gs = A->in[I_NORMG] + l * DM; J.WT = (bf16*)(ws + WS_WIN + l * WIN_STRIDE); J.K = DM; J.N = DIN; J.row_off = 0; J.perm_cols = l >= N_A ? DMAIN : 0; }
    else if (kind == 1) { J.W = A->in[I_WKV]; J.gs = A->in[I_KVNG]; J.WT = (bf16*)(ws + WS_WIN + N_A * WIN_STRIDE); J.K = DM; J.N = 256; J.row_off = DIN; J.perm_cols = 128; }
    else if (kind == 2) { J.W = A->in[I_WOUT] + (size_t)l * DCAT * DM; J.gs = nullptr; J.WT = (bf16*)(ws + WS_WOUT + l * WOUT_STRIDE); J.K = DCAT; J.N = DM; J.row_off = 0; J.perm_cols = 0; }
    else { J.W = A->in[I_WMEMKV] + (size_t)l * DM * DM; J.gs = A->in[I_MEMNG] + l * DM; J.WT = (bf16*)(ws + WS_WMEM + l * WMEM_STRIDE); J.K = DM; J.N = DM; J.row_off = 0; J.perm_cols = 0; }
    return J;
}
constexpr int WT_IN = (DM / 64) * (DIN / 256), WT_KV = DM / 64, WT_OUT = (DCAT / 64) * (DM / 256), WT_MEM = (DM / 64) * (DM / 256);
template <bool LATE> __device__ __forceinline__ void wlist_decode(ArgsP A, int it, WJob& J, int& tile) {
    if (!LATE) { const int l = it / WT_MEM; J = wjob(A, 3, l); tile = it - l * WT_MEM; return; }
    if (it < WT_IN) { J = wjob(A, 0, 0); tile = it; return; } it -= WT_IN;
    if (it < WT_OUT) { J = wjob(A, 2, 0); tile = it; return; } it -= WT_OUT;
    if (it < 3 * WT_IN) { const int l = 1 + it / WT_IN; J = wjob(A, 0, l); tile = it - (l - 1) * WT_IN; return; } it -= 3 * WT_IN;
    if (it < WT_KV) { J = wjob(A, 1, 0); tile = it; return; } it -= WT_KV;
    { const int l = 1 + it / WT_OUT; J = wjob(A, 2, l); tile = it - (l - 1) * WT_OUT; }
}
template <bool LATE> __device__ __forceinline__ void wlist_run(ArgsP A, LAS unsigned char* lds, int slot, int nslots) {
    constexpr int NIT = LATE ? (WT_IN + WT_OUT + 3 * WT_IN + WT_KV + 3 * WT_OUT) : (DEPTH * WT_MEM);
    int tid = threadIdx.x; asm volatile("" : "+v"(tid));
    LAS float* scr = (LAS float*)(lds + RING_OFF);
    float v[32]; WJob J; int tile;
    int it = slot;
    if (it < NIT) { wlist_decode<LATE>(A, it, J, tile); wtile_fetch(v, J, tile, tid); }
#pragma unroll 1
    for (; it < NIT; it += nslots) {
        wlist_decode<LATE>(A, it, J, tile);
        wtile_put(v, J, tile, tid, scr);
        __syncthreads();
        const int nx = it + nslots;
        if (nx < NIT) { WJob Jn; int tn; wlist_decode<LATE>(A, nx, Jn, tn); wtile_fetch(v, Jn, tn, tid); }
        __builtin_amdgcn_sched_barrier(0);
        wtile_store(J, tile, tid, scr);
        __syncthreads();
    }
}
__device__ __forceinline__ void p0_rows(ArgsP A, int m_lo, int m_hi, int wslot, int nslots) {
    const Ids I = make_ids();
    unsigned char* ws = A->ws;
    bf16* xb = (bf16*)(ws + WS_XB); float* rowsq0 = (float*)(ws + WS_ROWSQ);
    for (int m0 = m_lo + 2 * wslot; m0 < m_hi; m0 += 2 * nslots) {
        f32x4 v[2][4]; const float* src[2]; bf16* dst[2]; float* sq[2];
#pragma unroll
        for (int t = 0; t < 2; ++t) { const int m = m0 + t;
            if (m < MP) { src[t] = A->in[I_XP] + (size_t)m * DM; dst[t] = xb + (size_t)m * DM; sq[t] = rowsq0 + m; }
            else if (m < MV) { src[t] = A->in[I_XS] + (size_t)(m - MP) * DM; dst[t] = xb + (size_t)m * DM; sq[t] = rowsq0 + m; }
            else if (m < MPAD) { src[t] = nullptr; dst[t] = xb + (size_t)m * DM; sq[t] = rowsq0 + m; }
            else { const int mm = m - MPAD; src[t] = A->in[I_MEMP] + (size_t)mm * DM; dst[t] = (bf16*)(ws + WS_MEMB) + (size_t)mm * DM; sq[t] = (float*)(ws + WS_RSQM) + mm; }
#pragma unroll
            for (int j = 0; j < 4; ++j) v[t][j] = src[t] ? __builtin_nontemporal_load((const GAS f32x4*)src[t] + 2 * I.lane + (j & 1) + 128 * (j >> 1)) : (f32x4){0.f, 0.f, 0.f, 0.f}; }
        __builtin_amdgcn_sched_barrier(0);
#pragma unroll
        for (int t = 0; t < 2; ++t) { float s2 = 0.f;
#pragma unroll
            for (int j = 0; j < 4; ++j) s2 += (v[t][j].x * v[t][j].x + v[t][j].y * v[t][j].y) + (v[t][j].z * v[t][j].z + v[t][j].w * v[t][j].w);
            s2 = wave_sum(s2);
            GAS v4u* o16 = (GAS v4u*)dst[t] + I.lane;
#pragma unroll
            for (int hh = 0; hh < 2; ++hh) { v4u w; w.x = pk2(v[t][2 * hh].x, v[t][2 * hh].y); w.y = pk2(v[t][2 * hh].z, v[t][2 * hh].w); w.z = pk2(v[t][2 * hh + 1].x, v[t][2 * hh + 1].y); w.w = pk2(v[t][2 * hh + 1].z, v[t][2 * hh + 1].w); o16[64 * hh] = w; }
            if (I.lane == 0) *sq[t] = s2; }
    }
}
__device__ __forceinline__ void p0_rope(ArgsP A, int tslot, int ntslots) {
    float* rope = (float*)(A->ws + WS_ROPE);
    for (int e = tslot; e < (SEQ + 1) * 32; e += ntslots) { const int pos = e >> 5, i = e & 31; float c, s; sincos_f32arg((float)pos * INVF[i], c, s); rope[(size_t)pos * 64 + i] = c; rope[(size_t)pos * 64 + 32 + i] = s; }
}
__device__ __forceinline__ void p0_misc(ArgsP A, int tslot, int ntslots) {
    unsigned char* ws = A->ws;
    { bf16* wgt = (bf16*)(ws + WS_WG);
      for (int e = tslot; e < N_A * 2 * 16 * 4096; e += ntslots) { const int cin = e & 63, cout = (e >> 6) & 63, blk = (e >> 12) & 15, gate = (e >> 16) & 1, l = e >> 17;
          const float* src = (gate ? A->in[I_WX] : A->in[I_WA]) + ((size_t)(l * 16 + blk) * 64 + cin) * 64 + cout; wgt[e] = (bf16)f2bf(*src); } }
    for (int e0 = tslot; e0 < MS * 127 * 32; e0 += 4 * ntslots) {
        f32x4 kv[4], vv[4]; size_t off[4];
#pragma unroll
        for (int t = 0; t < 4; ++t) { const int e = e0 + t * ntslots; const bool ok = e < MS * 127 * 32; const int ee = ok ? e : 0; const int sb = ee / (127 * 32), rem = ee - sb * (127 * 32);
            off[t] = ok ? (size_t)sb * WIN * 128 + rem * 4 : (size_t)-1;
            if (ok) { kv[t] = __builtin_nontemporal_load((const f32x4*)(A->in[I_CWK] + off[t] + 128)); vv[t] = __builtin_nontemporal_load((const f32x4*)(A->in[I_CWV] + off[t] + 128)); } }
        __builtin_amdgcn_sched_barrier(0);
#pragma unroll
        for (int t = 0; t < 4; ++t) if (off[t] != (size_t)-1) { __builtin_nontemporal_store(kv[t], (f32x4*)(A->out + O_WKS + off[t])); __builtin_nontemporal_store(vv[t], (f32x4*)(A->out + O_WVS + off[t])); }
    }
}

__device__ __forceinline__ void final_norm_row(ArgsP A, int m, int lane) {
    const float* rsq = (const float*)(A->ws + WS_ROWSQ) + 4 * MPAD; const bf16* xb = (const bf16*)(A->ws + WS_XB);
    unsigned long long xv[4];
#pragma unroll
    for (int j = 0; j < 4; ++j) xv[j] = ((const GAS unsigned long long*)(xb + (size_t)m * DM))[lane + 64 * j];
    const float rs = 1.0f / sqrtf(rsq[m] * (1.0f / 1024.0f) + EPS);
    GAS f32x4* yr = (GAS f32x4*)(A->out + (size_t)m * DM) + lane; const GAS f32x4* gr = (const GAS f32x4*)A->in[I_FINALG] + lane;
#pragma unroll
    for (int j = 0; j < 4; ++j) { const unsigned lo = (unsigned)xv[j], hi = (unsigned)(xv[j] >> 32);
        const f32x4 x = {__builtin_bit_cast(float, lo << 16), __builtin_bit_cast(float, lo & 0xffff0000u), __builtin_bit_cast(float, hi << 16), __builtin_bit_cast(float, hi & 0xffff0000u)};
        yr[64 * j] = x * rs * gr[64 * j]; }
}
typedef short bf16x8 __attribute__((ext_vector_type(8)));
typedef float f32x16 __attribute__((ext_vector_type(16)));
typedef unsigned u32x2v __attribute__((ext_vector_type(2)));
__device__ __forceinline__ int crow(int r, int hi) { return (r & 3) + 8 * (r >> 2) + 4 * hi; }
typedef float f32x2_t __attribute__((ext_vector_type(2))); typedef __bf16 bf16x2_t __attribute__((ext_vector_type(2)));
__device__ __forceinline__ unsigned cvtpk(float lo, float hi) { f32x2_t v = {lo, hi}; bf16x2_t b = __builtin_convertvector(v, bf16x2_t); return __builtin_bit_cast(unsigned, b); }

template <int NKS> __device__ __forceinline__ f32x16 qk_tile(const LAS unsigned char* Kl, int KS, int kt, const bf16x8 (&qf)[NKS], int lane) {
    f32x16 acc = {0.f, 0.f, 0.f, 0.f, 0.f, 0.f, 0.f, 0.f, 0.f, 0.f, 0.f, 0.f, 0.f, 0.f, 0.f, 0.f};
    const LAS unsigned char* kp = Kl + (32 * kt + (lane & 31)) * KS + 16 * (lane >> 5);
#pragma unroll
    for (int ks = 0; ks < NKS; ++ks) { const bf16x8 kf = *(const LAS bf16x8*)(kp + 32 * ks); acc = __builtin_amdgcn_mfma_f32_32x32x16_bf16(kf, qf[ks], acc, 0, 0, 0); }
    __builtin_amdgcn_sched_barrier(0);
    return acc;
}
__device__ __forceinline__ void pack_tile(v4u (&pw)[2], const f32x16& p) {
#pragma unroll
    for (int s = 0; s < 2; ++s) { pw[s].x = cvtpk(p[8 * s + 0], p[8 * s + 1]); pw[s].y = cvtpk(p[8 * s + 2], p[8 * s + 3]); pw[s].z = cvtpk(p[8 * s + 4], p[8 * s + 5]); pw[s].w = cvtpk(p[8 * s + 6], p[8 * s + 7]); }
}
template <int NT> __device__ __forceinline__ f32x16 pv_block(const v4u (&pw)[NT][2], const LAS unsigned char* Vl, int VS, int d0, int kt0, int lane) {
    f32x16 o = {0.f, 0.f, 0.f, 0.f, 0.f, 0.f, 0.f, 0.f, 0.f, 0.f, 0.f, 0.f, 0.f, 0.f, 0.f, 0.f};
    const LAS unsigned char* vbase = Vl + (d0 + (lane & 31)) * VS + 8 * (lane >> 5) + 64 * kt0;
#pragma unroll
    for (int i = 0; i < NT; ++i)
#pragma unroll
        for (int s = 0; s < 2; ++s) {
            const LAS unsigned char* vp = vbase + 64 * i + 32 * s;
            const u32x2v lo = *(const LAS u32x2v*)vp, hi = *(const LAS u32x2v*)(vp + 16);
            v4u vw; vw.x = lo.x; vw.y = lo.y; vw.z = hi.x; vw.w = hi.y;
            o = __builtin_amdgcn_mfma_f32_32x32x16_bf16(__builtin_bit_cast(bf16x8, pw[i][s]), __builtin_bit_cast(bf16x8, vw), o, 0, 0, 0);
            if (s == 1 && (i & 1)) __builtin_amdgcn_sched_barrier(0);
        }
    __builtin_amdgcn_sched_barrier(0);
    return o;
}
__device__ __forceinline__ void store_gated(const f32x16& o, bf16* zrow0, const bf16* grow0, unsigned col, int lane) {
    const unsigned zo = (unsigned)(4 * (lane >> 5)) * DCAT + col, go = (unsigned)(4 * (lane >> 5)) * DIN + col;
#pragma unroll
    for (int g = 0; g < 4; ++g) {
        float gv[4];
#pragma unroll
        for (int i = 0; i < 4; ++i) gv[i] = bf2f(grow0[go + (unsigned)(8 * g + i) * DIN]);
#pragma unroll
        for (int i = 0; i < 4; ++i) zrow0[zo + (unsigned)(8 * g + i) * DCAT] = (bf16)f2bf(o[4 * g + i] * gv[i]);
        __builtin_amdgcn_sched_barrier(0);
    }
}
__device__ __forceinline__ void stage_write(LAS unsigned char* st, int RS, const f32x16& o, int db, int lane) {
    LAS unsigned short* p = (LAS unsigned short*)(st + (4 * (lane >> 5)) * RS + (32 * db + (lane & 31)) * 2);
#pragma unroll
    for (int e = 0; e < 16; e += 2) { const unsigned w = cvtpk(o[e], o[e + 1]);
        p[((e & 3) + 8 * (e >> 2)) * (RS / 2)] = (unsigned short)(w & 0xffffu); p[(((e + 1) & 3) + 8 * ((e + 1) >> 2)) * (RS / 2)] = (unsigned short)(w >> 16); }
}
__device__ __forceinline__ unsigned mul_bf16x2(unsigned a, unsigned b) {
    return cvtpk(__builtin_bit_cast(float, a << 16) * __builtin_bit_cast(float, b << 16), __builtin_bit_cast(float, a & 0xffff0000u) * __builtin_bit_cast(float, b & 0xffff0000u)); }
__device__ __forceinline__ v4u mul_bf16x8(const v4u a, const v4u b) { v4u r; r.x = mul_bf16x2(a.x, b.x); r.y = mul_bf16x2(a.y, b.y); r.z = mul_bf16x2(a.z, b.z); r.w = mul_bf16x2(a.w, b.w); return r; }
template <int CH> __device__ __forceinline__ void gate_load(v4u (&gate)[CH / 2], const bf16* grow0  , int lane) {
    const bf16* gp = grow0 + (size_t)(lane / CH) * DIN + (lane % CH) * 8;
#pragma unroll
    for (int j = 0; j < CH / 2; ++j) gate[j] = *(const v4u*)(gp + (size_t)((64 / CH) * j) * DIN);
}
template <int CH> __device__ __forceinline__ void stage_store(const LAS unsigned char* st, int RS, const v4u (&gate)[CH / 2], bf16* zrow0  , int lane) {
    const LAS unsigned char* sp = st + (lane / CH) * RS + (lane % CH) * 16; bf16* zp = zrow0 + (size_t)(lane / CH) * DCAT + (lane % CH) * 8;
#pragma unroll
    for (int j = 0; j < CH / 2; ++j) { const v4u o = *(const LAS v4u*)(sp + ((64 / CH) * j) * RS); *(v4u*)(zp + (size_t)((64 / CH) * j) * DCAT) = mul_bf16x8(o, gate[j]); }
}

constexpr int SWA_KS = 144, SWA_VS = 520;
constexpr int SWA_K_OFF = 0, SWA_V_OFF = 256 * SWA_KS, SWA_ST_OFF = SWA_V_OFF + 64 * SWA_VS, SWA_ST_RS = 144;
__device__ __forceinline__ void swa_unit(ArgsP A, const Ids& I, int l, int unit, LAS unsigned char* lds) {
    const int b = unit >> 7, n = (unit >> 1) & 63, kvh = unit & 1;
    const bf16* proj = (const bf16*)(A->ws + WS_PROJ); bf16* z = (bf16*)(A->ws + WS_Z);
    const bf16* kb = (const bf16*)(A->ws + WS_KB); const bf16* vb = (const bf16*)(A->ws + WS_VB);
    LAS unsigned char* Kl = lds + SWA_K_OFF; LAS unsigned char* Vl = lds + SWA_V_OFF;
    const long tok0 = (long)b * SEQ + 128 * (n - 1);
    int tid_o = I.tid; asm volatile("" : "+v"(tid_o));
#pragma unroll
    for (int j = 0; j < 4; ++j) { const int row = (tid_o & 63) + 64 * ((tid_o >> 6) & 3), ch = 4 * (tid_o >> 8) + j;
        {
            v4u kv = {0u, 0u, 0u, 0u}, vv = {0u, 0u, 0u, 0u};
            if (n > 0 || row >= 128) { kv = *(const v4u*)(kb + (size_t)(tok0 + row) * 128 + kvh * 64 + ch * 8); vv = *(const v4u*)(vb + (size_t)(tok0 + row) * 128 + kvh * 64 + ch * 8); }
            *(LAS v4u*)(Kl + row * SWA_KS + ch * 16) = kv;
            LAS unsigned short* vt = (LAS unsigned short*)(Vl + (ch * 8) * SWA_VS + row * 2);
            vt[0 * (SWA_VS / 2)] = (unsigned short)(vv.x & 0xffffu); vt[1 * (SWA_VS / 2)] = (unsigned short)(vv.x >> 16);
            vt[2 * (SWA_VS / 2)] = (unsigned short)(vv.y & 0xffffu); vt[3 * (SWA_VS / 2)] = (unsigned short)(vv.y >> 16);
            vt[4 * (SWA_VS / 2)] = (unsigned short)(vv.z & 0xffffu); vt[5 * (SWA_VS / 2)] = (unsigned short)(vv.z >> 16);
            vt[6 * (SWA_VS / 2)] = (unsigned short)(vv.w & 0xffffu); vt[7 * (SWA_VS / 2)] = (unsigned short)(vv.w >> 16);
        }
    }
    __syncthreads();
    const int h = kvh * 8 + I.wave;
    const float sink2 = A->in[I_SINKS][(l - N_A) * NHEADS + h] * LOG2E;
    const size_t row0 = (size_t)b * SEQ + 128 * n;
    bf16x8 qfb[2][4]; v4u gateb[2][4];
    { int lane0 = tid_o & 63; asm volatile("" : "+v"(lane0));
      const bf16* qp = proj + (row0 + (lane0 & 31)) * DIN + h * 64 + 8 * (lane0 >> 5);
#pragma unroll
      for (int ks = 0; ks < 4; ++ks) qfb[0][ks] = *(const bf16x8*)(qp + 16 * ks);
      gate_load<8>(gateb[0], proj + row0 * DIN + DMAIN + h * 64, lane0); }
#pragma unroll
    for (int r = 0; r < 4; ++r) {
        int lane = tid_o & 63; asm volatile("" : "+v"(lane));
        const int q = lane & 31, hi = lane >> 5;
        if (r < 3) { const bf16* qp = proj + (row0 + 32 * (r + 1) + q) * DIN + h * 64 + 8 * hi;
#pragma unroll
            for (int ks = 0; ks < 4; ++ks) qfb[(r + 1) & 1][ks] = *(const bf16x8*)(qp + 16 * ks);
            gate_load<8>(gateb[(r + 1) & 1], proj + (row0 + 32 * (r + 1)) * DIN + DMAIN + h * 64, lane); }
        __builtin_amdgcn_sched_barrier(0);
        const bf16x8 (&qf)[4] = qfb[r & 1]; const v4u (&gate)[4] = gateb[r & 1];
        f32x16 s[5];
#pragma unroll
        for (int i = 0; i < 5; ++i) s[i] = qk_tile<4>(Kl, SWA_KS, r + i, qf, lane);
        const float NEG = -1.0e30f;
        {
            const int dbase = 4 * hi - q; const unsigned NEGB = __builtin_bit_cast(unsigned, NEG), MAXB = 0x7f7fffffu;
#pragma unroll
            for (int e = 0; e < 16; ++e) { const int d = dbase + (e & 3) + 8 * (e >> 2);
                const unsigned m0 = ((unsigned)((d - 1) >> 31) & (NEGB ^ MAXB)) ^ MAXB, m4 = ((unsigned)((-d) >> 31) & (NEGB ^ MAXB)) ^ MAXB;
                s[0][e] = fminf(s[0][e], __builtin_bit_cast(float, m0)); s[4][e] = fminf(s[4][e], __builtin_bit_cast(float, m4)); }
        }
        if (n == 0) {
#pragma unroll
            for (int i = 0; i < 4; ++i) if (r + i < 4) {
#pragma unroll
                for (int e = 0; e < 16; ++e) s[i][e] = NEG; }
        }
        float mx = NEG;
#pragma unroll
        for (int i = 0; i < 5; ++i)
#pragma unroll
            for (int e = 0; e < 16; ++e) mx = fmaxf(mx, s[i][e]);
        mx = fmaxf(mx, __shfl_xor(mx, 32)); mx = fmaxf(mx, sink2);
        float sum = 0.f;
#pragma unroll
        for (int i = 0; i < 5; ++i)
#pragma unroll
            for (int e = 0; e < 16; ++e) { const float p = __builtin_amdgcn_exp2f(s[i][e] - mx); s[i][e] = p; sum += p; }
        sum += __shfl_xor(sum, 32); sum += __builtin_amdgcn_exp2f(sink2 - mx);
        const float inv = 1.0f / sum;
        v4u pw[5][2];
#pragma unroll
        for (int i = 0; i < 5; ++i) {
#pragma unroll
            for (int e = 0; e < 16; ++e) s[i][e] *= inv;
            pack_tile(pw[i], s[i]);
        }
        LAS unsigned char* st = lds + SWA_ST_OFF + I.wave * (32 * SWA_ST_RS);
#pragma unroll
        for (int db = 0; db < 2; ++db) { const f32x16 o = pv_block<5>(pw, Vl, SWA_VS, 32 * db, r, lane); stage_write(st, SWA_ST_RS, o, db, lane); }
        stage_store<8>(st, SWA_ST_RS, gate, z + (row0 + 32 * r) * DCAT + h * 64, lane);
    }
    __syncthreads();
}

constexpr int MEM_KS = 272, MEM_VS = 520;
constexpr int MEM_K_OFF = 0, MEM_V_OFF = 256 * MEM_KS;
__device__ __forceinline__ void mem_unit(ArgsP A, const Ids& I, int l, int unit, LAS unsigned char* lds) {
    const int b = unit >> 7, np = (unit >> 2) & 31, mh = unit & 3;
    const bf16* proj = (const bf16*)(A->ws + WS_PROJ); bf16* z = (bf16*)(A->ws + WS_Z);
    const bf16* mk = (const bf16*)(A->ws + WS_MKB) + (size_t)(l * 512 + b * 256) * 512 + mh * 128;
    const bf16* mv = (const bf16*)(A->ws + WS_MVB) + (size_t)(l * 512 + b * 256) * 512 + mh * 128;
    LAS unsigned char* Kl = lds + MEM_K_OFF; LAS unsigned char* Vl = lds + MEM_V_OFF;
    int tid_o = I.tid; asm volatile("" : "+v"(tid_o));
#pragma unroll
    for (int j = 0; j < 8; ++j) { const int row = (tid_o & 63) + 64 * ((tid_o >> 6) & 3), ch = 8 * (tid_o >> 8) + j;
        const v4u kv = *(const v4u*)(mk + (size_t)row * 512 + ch * 8);
        const v4u vv = *(const v4u*)(mv + (size_t)row * 512 + ch * 8);
        *(LAS v4u*)(Kl + row * MEM_KS + ch * 16) = kv;
        LAS unsigned short* vt = (LAS unsigned short*)(Vl + (ch * 8) * MEM_VS + row * 2);
        vt[0 * (MEM_VS / 2)] = (unsigned short)(vv.x & 0xffffu); vt[1 * (MEM_VS / 2)] = (unsigned short)(vv.x >> 16);
        vt[2 * (MEM_VS / 2)] = (unsigned short)(vv.y & 0xffffu); vt[3 * (MEM_VS / 2)] = (unsigned short)(vv.y >> 16);
        vt[4 * (MEM_VS / 2)] = (unsigned short)(vv.z & 0xffffu); vt[5 * (MEM_VS / 2)] = (unsigned short)(vv.z >> 16);
        vt[6 * (MEM_VS / 2)] = (unsigned short)(vv.w & 0xffffu); vt[7 * (MEM_VS / 2)] = (unsigned short)(vv.w >> 16);
    }
    __syncthreads();
    const int lane = tid_o & 63, q = lane & 31, hi = lane >> 5;
    const size_t row0 = (size_t)b * SEQ + 256 * np + 32 * I.wave;
    v4u gate[8]; gate_load<16>(gate, proj + row0 * DIN + 2560 + mh * 128, lane);
    v4u pw[8][2];
    {
        bf16x8 qf[8];
        { const bf16* qp = proj + (row0 + q) * DIN + 2048 + mh * 128 + 8 * hi;
#pragma unroll
          for (int ks = 0; ks < 8; ++ks) qf[ks] = *(const bf16x8*)(qp + 16 * ks); }
        f32x16 s[8];
#pragma unroll
        for (int i = 0; i < 8; ++i) s[i] = qk_tile<8>(Kl, MEM_KS, i, qf, lane);
        float mx = -1.0e30f;
#pragma unroll
        for (int i = 0; i < 8; ++i)
#pragma unroll
            for (int e = 0; e < 16; ++e) mx = fmaxf(mx, s[i][e]);
        mx = fmaxf(mx, __shfl_xor(mx, 32));
        float sum = 0.f;
#pragma unroll
        for (int i = 0; i < 8; ++i)
#pragma unroll
            for (int e = 0; e < 16; ++e) { const float p = __builtin_amdgcn_exp2f(s[i][e] - mx); s[i][e] = p; sum += p; }
        sum += __shfl_xor(sum, 32);
        const float inv = 1.0f / sum;
#pragma unroll
        for (int i = 0; i < 8; ++i) {
#pragma unroll
            for (int e = 0; e < 16; ++e) s[i][e] *= inv;
            pack_tile(pw[i], s[i]);
        }
    }
    __syncthreads();
    LAS unsigned char* st = Kl + I.wave * (32 * MEM_KS);
#pragma unroll
    for (int db = 0; db < 4; ++db) { const f32x16 o = pv_block<8>(pw, Vl, MEM_VS, 32 * db, 0, lane); stage_write(st, MEM_KS, o, db, lane); }
    stage_store<16>(st, MEM_KS, gate, z + row0 * DCAT + DMAIN + mh * 128, lane);
    __syncthreads();
}
constexpr int LRU_U = 0, LRU_UC = 18880, LRU_UCF = 37312, LRU_AGGW = 70080, LRU_HC = 72128, LRU_HST = 72384;
constexpr int LRU_RS = 144;
typedef float f32x2v __attribute__((ext_vector_type(2)));

struct LruConst { bf16x8 wa[4], wx[4]; float ba, bx, c1; };
__device__ __forceinline__ void lru_load_const(LruConst& C, ArgsP A, int l, int cb, int ct, int lane) {
    const int q = lane & 31, hi = lane >> 5, ch = cb * 64 + ct * 32 + q;
    const bf16* wg = (const bf16*)(A->ws + WS_WG) + ((size_t)((l * 2) * 16 + cb) * 64 + ct * 32 + q) * 64 + 8 * hi;
#pragma unroll
    for (int ks = 0; ks < 4; ++ks) { C.wa[ks] = *(const bf16x8*)(wg + 16 * ks); C.wx[ks] = *(const bf16x8*)(wg + 16 * 64 * 64 + 16 * ks); }
    C.ba = A->in[I_BA][l * DMAIN + ch]; C.bx = A->in[I_BX][l * DMAIN + ch];
    C.c1 = -8.0f * LOG2E * log1pf(expf(-A->in[I_LAM][l * DMAIN + ch]));
}
__device__ __forceinline__ void lru_gates(const LruConst& C, int rt, int ct, int lane, LAS unsigned char* lds, f32x16& a, f32x16& bt, f32x16& la) {
    const int q = lane & 31, hi = lane >> 5;
    f32x16 ga = {0.f, 0.f, 0.f, 0.f, 0.f, 0.f, 0.f, 0.f, 0.f, 0.f, 0.f, 0.f, 0.f, 0.f, 0.f, 0.f}, gx = ga;
    const LAS unsigned char* up = lds + LRU_UC + (rt * 32 + q) * LRU_RS + 16 * hi;
#pragma unroll
    for (int ks = 0; ks < 4; ++ks) {
        const bf16x8 uf = *(const LAS bf16x8*)(up + 32 * ks);
        ga = __builtin_amdgcn_mfma_f32_32x32x16_bf16(uf, C.wa[ks], ga, 0, 0, 0);
        gx = __builtin_amdgcn_mfma_f32_32x32x16_bf16(uf, C.wx[ks], gx, 0, 0, 0);
    }
    const LAS float* ucf = (const LAS float*)(lds + LRU_UCF) + (rt * 32 + 4 * hi) * 64 + ct * 32 + q;
#pragma unroll
    for (int e = 0; e < 16; ++e) {
        const float uc = ucf[((e & 3) + 8 * (e >> 2)) * 64];
        const float rg = __builtin_amdgcn_rcpf(1.0f + __builtin_amdgcn_exp2f(-(ga[e] + C.ba) * LOG2E));
        const float ig = __builtin_amdgcn_rcpf(1.0f + __builtin_amdgcn_exp2f(-(gx[e] + C.bx) * LOG2E));
        const float lav = C.c1 * rg, av = __builtin_amdgcn_exp2f(lav);
        la[e] = lav; a[e] = av; bt[e] = __builtin_amdgcn_sqrtf(fmaxf(1.0f - av * av, 0.f)) * (ig * uc);
    }
}
__device__ __forceinline__ void lru_wave_scan(const f32x16& a, const f32x16& bt, int hi, f32x16& Ap, f32x16& Hp, float (&cp)[4], float (&cq)[4], float& Pt, float& Qt) {
    float mp[4], mq[4];
#pragma unroll
    for (int g = 0; g < 4; ++g) { float P = 1.f, Q = 0.f;
#pragma unroll
        for (int i = 0; i < 4; ++i) { Q = a[4 * g + i] * Q + bt[4 * g + i]; P = a[4 * g + i] * P; Ap[4 * g + i] = P; Hp[4 * g + i] = Q; }
        mp[g] = P; mq[g] = Q; }
    float Pc = 1.f, Qc = 0.f;
#pragma unroll
    for (int g = 0; g < 4; ++g) {
        const float op = __shfl_xor(mp[g], 32), oq = __shfl_xor(mq[g], 32);
        const float p0 = hi ? op : mp[g], q0 = hi ? oq : mq[g], p1 = hi ? mp[g] : op, q1 = hi ? mq[g] : oq;
        const float Pa = p0 * Pc, Qa = p0 * Qc + q0;
        cp[g] = hi ? Pa : Pc; cq[g] = hi ? Qa : Qc;
        Pc = p1 * Pa; Qc = p1 * Qa + q1;
    }
    Pt = Pc; Qt = Qc;
}
struct LruConvW { f32x4 w[4][2], bb[2]; };
__device__ __forceinline__ void lru_load_convw(LruConvW& W, ArgsP A, int l, int cb, int tid) {
    const int c8 = tid & 7;
    const float* cw = A->in[I_CONVW] + (size_t)l * 4 * DMAIN + cb * 64 + 8 * c8;
#pragma unroll
    for (int k = 0; k < 4; ++k) { W.w[k][0] = *(const f32x4*)(cw + k * DMAIN); W.w[k][1] = *(const f32x4*)(cw + k * DMAIN + 4); }
    W.bb[0] = *(const f32x4*)(A->in[I_CONVB] + l * DMAIN + cb * 64 + 8 * c8); W.bb[1] = *(const f32x4*)(A->in[I_CONVB] + l * DMAIN + cb * 64 + 8 * c8 + 4);
}
__device__ __forceinline__ void lru_conv_prompt(const LruConvW& W, int tid, LAS unsigned char* lds) {
    const int c8 = tid & 7;
#pragma unroll
    for (int j = 0; j < 2; ++j) { const int t = (tid >> 3) + 64 * j;
        f32x4 o0 = W.bb[0], o1 = W.bb[1];
#pragma unroll
        for (int k = 0; k < 4; ++k) { const v4u uv = *(const LAS v4u*)(lds + LRU_U + (t + k) * LRU_RS + c8 * 16);
            const f32x4 u0 = {__builtin_bit_cast(float, uv.x << 16), __builtin_bit_cast(float, uv.x & 0xffff0000u), __builtin_bit_cast(float, uv.y << 16), __builtin_bit_cast(float, uv.y & 0xffff0000u)};
            const f32x4 u1 = {__builtin_bit_cast(float, uv.z << 16), __builtin_bit_cast(float, uv.z & 0xffff0000u), __builtin_bit_cast(float, uv.w << 16), __builtin_bit_cast(float, uv.w & 0xffff0000u)};
            o0 += u0 * W.w[k][0]; o1 += u1 * W.w[k][1]; }
        v4u pk; pk.x = pk2(o0[0], o0[1]); pk.y = pk2(o0[2], o0[3]); pk.z = pk2(o1[0], o1[1]); pk.w = pk2(o1[2], o1[3]);
        *(LAS v4u*)(lds + LRU_UC + t * LRU_RS + c8 * 16) = pk;
        LAS f32x4* uf = (LAS f32x4*)(lds + LRU_UCF + t * 256 + c8 * 32); uf[0] = o0; uf[1] = o1; }
}
template <int PASS> __device__ __forceinline__ void lru_prompt_pass(ArgsP A, const Ids& I, int l, LAS unsigned char* lds) {
    const int vcu = I.gw >> 3, chain = vcu >> 3, sg = vcu & 7, b = chain >> 4, cb = chain & 15;
    const bf16* proj = (const bf16*)(A->ws + WS_PROJ); bf16* z = (bf16*)(A->ws + WS_Z);
    f32x2v* agg = (f32x2v*)(A->ws + WS_AGG) + (size_t)l * 256 * 64;
    LAS float* HC = (LAS float*)(lds + LRU_HC); LAS f32x2v* AGGW = (LAS f32x2v*)(lds + LRU_AGGW);
    int tid = I.tid; asm volatile("" : "+v"(tid));
    const int lane = tid & 63, hi = lane >> 5, rt = I.wave >> 1, ct = I.wave & 1;
    LruConst C; lru_load_const(C, A, l, cb, ct, lane);
    LruConvW W; lru_load_convw(W, A, l, cb, tid);
    float Pseg = 1.f, Qseg = 0.f;
    v4u un[3];
#define LRU_FETCH(c_) do { const long r0_ = (long)b * SEQ + 128 * (c_); _Pragma("unroll") for (int j = 0; j < 3; ++j) { const int id = tid + 512 * j; un[j] = (v4u){0u, 0u, 0u, 0u}; \
        if (id < 131 * 8) { const int row = id >> 3, c8 = id & 7; if ((c_) > 0 || row >= 3) un[j] = *(const v4u*)(proj + (size_t)(r0_ - 3 + row) * DIN + cb * 64 + c8 * 8); } } } while (0)
    LRU_FETCH(sg * 8);
    if (PASS == 2) {
        if (I.wave == 0) {
            unsigned* fl = (unsigned*)(A->ws + WS_CTL) + CW_LRUF + (size_t)(l * 256 + chain * 8) * 64;
            unsigned spins = 0;
            while (true) { const unsigned f = lane < sg ? __hip_atomic_load(fl + lane * 64, __ATOMIC_RELAXED, __HIP_MEMORY_SCOPE_AGENT) : 1u;
                if (__all(f != 0u) || ++spins > (1u << 22)) break; __builtin_amdgcn_s_sleep(2); }
            __builtin_amdgcn_fence(__ATOMIC_ACQUIRE, "agent");
            asm volatile("s_waitcnt vmcnt(0)" ::: "memory");
            float h = 0.f;
            for (int s2 = 0; s2 < sg; ++s2) { const f32x2v m = agg[(size_t)(chain * 8 + s2) * 64 + lane]; h = m.x * h + m.y; }
            HC[lane] = h; }
    }
#pragma unroll 1
    for (int ci = 0; ci < 8; ++ci) {
        const int c = sg * 8 + ci;
        const long row0 = (long)b * SEQ + 128 * c;
#pragma unroll
        for (int j = 0; j < 3; ++j) { const int id = tid + 512 * j;
            if (id < 131 * 8) { const int row = id >> 3, c8 = id & 7; const v4u v = un[j];
                *(LAS v4u*)(lds + LRU_U + row * LRU_RS + c8 * 16) = v;
                if (PASS == 1 && c == 63 && row >= 128) { float* oc = A->out + O_CP + ((size_t)(l * NB + b) * 3 + (row - 128)) * DMAIN + cb * 64 + c8 * 8;
                    *(f32x4*)oc = (f32x4){__builtin_bit_cast(float, v.x << 16), __builtin_bit_cast(float, v.x & 0xffff0000u), __builtin_bit_cast(float, v.y << 16), __builtin_bit_cast(float, v.y & 0xffff0000u)};
                    *(f32x4*)(oc + 4) = (f32x4){__builtin_bit_cast(float, v.z << 16), __builtin_bit_cast(float, v.z & 0xffff0000u), __builtin_bit_cast(float, v.w << 16), __builtin_bit_cast(float, v.w & 0xffff0000u)}; } } }
        if (ci < 7) LRU_FETCH(c + 1);
        v4u gate[2];
        if (PASS == 2) { const bf16* gp = proj + (size_t)(row0 + (tid >> 3)) * DIN + DMAIN + cb * 64 + (tid & 7) * 8; gate[0] = *(const v4u*)gp; gate[1] = *(const v4u*)(gp + (size_t)64 * DIN); }
        __syncthreads();
        lru_conv_prompt(W, tid, lds);
        __syncthreads();
        f32x16 a, bt, la; lru_gates(C, rt, ct, lane, lds, a, bt, la);
        if (PASS == 1) {
            v4u* lab = (v4u*)((unsigned*)(A->ws + WS_LAB) + (size_t)l * (16u << 20) + ((size_t)((chain * 64 + c) * 8 + I.wave) * 16) * 64) + lane;
#pragma unroll
            for (int q4 = 0; q4 < 4; ++q4) { v4u w; w.x = cvtpk(la[4 * q4], bt[4 * q4]); w.y = cvtpk(la[4 * q4 + 1], bt[4 * q4 + 1]); w.z = cvtpk(la[4 * q4 + 2], bt[4 * q4 + 2]); w.w = cvtpk(la[4 * q4 + 3], bt[4 * q4 + 3]);
                __builtin_nontemporal_store(w, lab + q4 * 64); } }
        f32x16 Ap, Hp; float cp[4], cq[4], Pt, Qt;
        lru_wave_scan(a, bt, hi, Ap, Hp, cp, cq, Pt, Qt);
        if (hi == 0) AGGW[rt * 64 + ct * 32 + (lane & 31)] = (f32x2v){Pt, Qt};
        __syncthreads();
        if (PASS == 1) {
            if (I.wave == 0) {
#pragma unroll
                for (int r2 = 0; r2 < 4; ++r2) { const f32x2v m = AGGW[r2 * 64 + lane]; Qseg = m.x * Qseg + m.y; Pseg = m.x * Pseg; } }
        } else {
            float hin = HC[ct * 32 + (lane & 31)];
            for (int r2 = 0; r2 < rt; ++r2) { const f32x2v m = AGGW[r2 * 64 + ct * 32 + (lane & 31)]; hin = m.x * hin + m.y; }
            f32x16 h;
#pragma unroll
            for (int g = 0; g < 4; ++g) { const float hs = cp[g] * hin + cq[g];
#pragma unroll
                for (int i = 0; i < 4; ++i) h[4 * g + i] = Ap[4 * g + i] * hs + Hp[4 * g + i]; }
            stage_write(lds + LRU_HST + (32 * rt) * LRU_RS, LRU_RS, h, ct, lane);
            __syncthreads();
            if (rt == 3 && hi == 1) { HC[ct * 32 + (lane & 31)] = h[15];
                if (c == 63) A->out[O_HP + (size_t)(l * NB + b) * DMAIN + cb * 64 + ct * 32 + (lane & 31)] = h[15]; }
            { const LAS unsigned char* sp = lds + LRU_HST + (tid >> 3) * LRU_RS + (tid & 7) * 16; bf16* zp = z + (size_t)(row0 + (tid >> 3)) * DCAT + cb * 64 + (tid & 7) * 8;
              *(v4u*)zp = mul_bf16x8(*(const LAS v4u*)sp, gate[0]); *(v4u*)(zp + (size_t)64 * DCAT) = mul_bf16x8(*(const LAS v4u*)(sp + 64 * LRU_RS), gate[1]); }
        }
    }
#undef LRU_FETCH
    if (PASS == 1) { if (I.wave == 0) {
            agg[(size_t)(chain * 8 + sg) * 64 + lane] = (f32x2v){Pseg, Qseg};
            asm volatile("s_waitcnt vmcnt(0)" ::: "memory");
            if (lane == 0) { __builtin_amdgcn_fence(__ATOMIC_RELEASE, "agent"); asm volatile("s_waitcnt vmcnt(0)" ::: "memory");
                __hip_atomic_store((unsigned*)(A->ws + WS_CTL) + CW_LRUF + (size_t)(l * 256 + chain * 8 + sg) * 64, 1u, __ATOMIC_RELAXED, __HIP_MEMORY_SCOPE_AGENT); } } }
    __syncthreads();
}
__device__ __forceinline__ void lru_prompt_pass2(ArgsP A, const Ids& I, int l, LAS unsigned char* lds) {
    const int vcu = I.gw >> 3, chain = vcu >> 3, sg = vcu & 7, b = chain >> 4, cb = chain & 15;
    const bf16* proj = (const bf16*)(A->ws + WS_PROJ); bf16* z = (bf16*)(A->ws + WS_Z);
    const f32x2v* agg = (const f32x2v*)(A->ws + WS_AGG) + (size_t)l * 256 * 64;
    LAS float* HC = (LAS float*)(lds + LRU_HC); LAS f32x2v* AGGW = (LAS f32x2v*)(lds + LRU_AGGW);
    int tid = I.tid; asm volatile("" : "+v"(tid));
    const int lane = tid & 63, hi = lane >> 5, rt = I.wave >> 1, ct = I.wave & 1;
    const v4u* lab0 = (const v4u*)((const unsigned*)(A->ws + WS_LAB) + (size_t)l * (16u << 20) + ((size_t)((chain * 64 + sg * 8) * 8 + I.wave) * 16) * 64) + lane;
    v4u wv[2][4]; v4u gate[2][2];
#define LRU2_FETCH(slot_, ci_) do { _Pragma("unroll") for (int q4 = 0; q4 < 4; ++q4) wv[slot_][q4] = __builtin_nontemporal_load(lab0 + (size_t)(ci_) * (8 * 4 * 64) + q4 * 64); \
        const bf16* gp_ = proj + (size_t)((long)b * SEQ + 128 * (sg * 8 + (ci_)) + (tid >> 3)) * DIN + DMAIN + cb * 64 + (tid & 7) * 8; gate[slot_][0] = *(const v4u*)gp_; gate[slot_][1] = *(const v4u*)(gp_ + (size_t)64 * DIN); } while (0)
    if (I.wave == 0) {
        unsigned* fl = (unsigned*)(A->ws + WS_CTL) + CW_LRUF + (size_t)(l * 256 + chain * 8) * 64;
        unsigned spins = 0;
        while (true) { const unsigned f = lane < sg ? __hip_atomic_load(fl + lane * 64, __ATOMIC_RELAXED, __HIP_MEMORY_SCOPE_AGENT) : 1u;
            if (__all(f != 0u) || ++spins > (1u << 22)) break; __builtin_amdgcn_s_sleep(2); }
        __builtin_amdgcn_fence(__ATOMIC_ACQUIRE, "agent");
        asm volatile("s_waitcnt vmcnt(0)" ::: "memory");
        float h = 0.f;
        for (int s2 = 0; s2 < sg; ++s2) { const f32x2v m = agg[(size_t)(chain * 8 + s2) * 64 + lane]; h = m.x * h + m.y; }
        HC[lane] = h; }
    LRU2_FETCH(0, 0);
#pragma unroll
    for (int ci = 0; ci < 8; ++ci) {
        const int c = sg * 8 + ci; const long row0 = (long)b * SEQ + 128 * c;
        if (ci < 7) LRU2_FETCH((ci + 1) & 1, ci + 1);
        __builtin_amdgcn_sched_barrier(0);
        f32x16 a, bt;
#pragma unroll
        for (int e = 0; e < 16; ++e) { const unsigned w = wv[ci & 1][e >> 2][e & 3]; a[e] = __builtin_amdgcn_exp2f(__builtin_bit_cast(float, w << 16)); bt[e] = __builtin_bit_cast(float, w & 0xffff0000u); }
        f32x16 Ap, Hp; float cp[4], cq[4], Pt, Qt;
        lru_wave_scan(a, bt, hi, Ap, Hp, cp, cq, Pt, Qt);
        if (hi == 0) AGGW[rt * 64 + ct * 32 + (lane & 31)] = (f32x2v){Pt, Qt};
        __syncthreads();
        float hin = HC[ct * 32 + (lane & 31)];
        for (int r2 = 0; r2 < rt; ++r2) { const f32x2v m = AGGW[r2 * 64 + ct * 32 + (lane & 31)]; hin = m.x * hin + m.y; }
        f32x16 h;
#pragma unroll
        for (int g = 0; g < 4; ++g) { const float hs = cp[g] * hin + cq[g];
#pragma unroll
            for (int i = 0; i < 4; ++i) h[4 * g + i] = Ap[4 * g + i] * hs + Hp[4 * g + i]; }
        stage_write(lds + LRU_HST + (32 * rt) * LRU_RS, LRU_RS, h, ct, lane);
        __syncthreads();
        if (rt == 3 && hi == 1) { HC[ct * 32 + (lane & 31)] = h[15];
            if (c == 63) A->out[O_HP + (size_t)(l * NB + b) * DMAIN + cb * 64 + ct * 32 + (lane & 31)] = h[15]; }
        { const LAS unsigned char* sp = lds + LRU_HST + (tid >> 3) * LRU_RS + (tid & 7) * 16; bf16* zp = z + (size_t)(row0 + (tid >> 3)) * DCAT + cb * 64 + (tid & 7) * 8;
          *(v4u*)zp = mul_bf16x8(*(const LAS v4u*)sp, gate[ci & 1][0]); *(v4u*)(zp + (size_t)64 * DCAT) = mul_bf16x8(*(const LAS v4u*)(sp + 64 * LRU_RS), gate[ci & 1][1]); }
    }
#undef LRU2_FETCH
    __syncthreads();
}
__device__ __forceinline__ void lru_sample_item(ArgsP A, const Ids& I, int l, int item, LAS unsigned char* lds) {
    const int cb = item >> 2, rq = item & 3;
    const bf16* proj = (const bf16*)(A->ws + WS_PROJ); bf16* z = (bf16*)(A->ws + WS_Z);
    int tid = I.tid; asm volatile("" : "+v"(tid));
    const int lane = tid & 63, hi = lane >> 5, ct = I.wave & 1;
    const int chn = cb * 64 + ct * 32 + (lane & 31);
    float h0[16]; bf16 gz[16];
    LruConst C;
    if (I.wave < 2) {
        lru_load_const(C, A, l, cb, ct, lane);
#pragma unroll
        for (int e = 0; e < 16; ++e) { const int sb = 32 * rq + crow(e, hi); h0[e] = A->in[I_STH][(size_t)(l * MS + sb) * DMAIN + chn]; gz[e] = proj[(size_t)(MP + sb) * DIN + DMAIN + chn]; }
    }
    if (tid < 256) {
        const int c8 = tid & 7, sb = 32 * rq + (tid >> 3);
        const float* cw = A->in[I_CONVW] + (size_t)l * 4 * DMAIN + cb * 64 + 8 * c8;
        const float* sc = A->in[I_STC] + (size_t)(l * MS + sb) * 3 * DMAIN + cb * 64 + 8 * c8;
        float* oc = A->out + O_CS + (size_t)(l * MS + sb) * 3 * DMAIN + cb * 64 + 8 * c8;
        const v4u uv = *(const v4u*)(proj + (size_t)(MP + sb) * DIN + cb * 64 + c8 * 8);
        f32x4 x[4][2], w[4][2];
#pragma unroll
        for (int k = 0; k < 3; ++k) { x[k][0] = *(const f32x4*)(sc + k * DMAIN); x[k][1] = *(const f32x4*)(sc + k * DMAIN + 4); }
#pragma unroll
        for (int k = 0; k < 4; ++k) { w[k][0] = *(const f32x4*)(cw + k * DMAIN); w[k][1] = *(const f32x4*)(cw + k * DMAIN + 4); }
        f32x4 o0 = *(const f32x4*)(A->in[I_CONVB] + l * DMAIN + cb * 64 + 8 * c8), o1 = *(const f32x4*)(A->in[I_CONVB] + l * DMAIN + cb * 64 + 8 * c8 + 4);
        x[3][0] = (f32x4){__builtin_bit_cast(float, uv.x << 16), __builtin_bit_cast(float, uv.x & 0xffff0000u), __builtin_bit_cast(float, uv.y << 16), __builtin_bit_cast(float, uv.y & 0xffff0000u)};
        x[3][1] = (f32x4){__builtin_bit_cast(float, uv.z << 16), __builtin_bit_cast(float, uv.z & 0xffff0000u), __builtin_bit_cast(float, uv.w << 16), __builtin_bit_cast(float, uv.w & 0xffff0000u)};
#pragma unroll
        for (int k = 0; k < 4; ++k) { o0 += x[k][0] * w[k][0]; o1 += x[k][1] * w[k][1]; }
#pragma unroll
        for (int k = 0; k < 3; ++k) { *(f32x4*)(oc + k * DMAIN) = x[k + 1][0]; *(f32x4*)(oc + k * DMAIN + 4) = x[k + 1][1]; }
        v4u pk; pk.x = pk2(o0[0], o0[1]); pk.y = pk2(o0[2], o0[3]); pk.z = pk2(o1[0], o1[1]); pk.w = pk2(o1[2], o1[3]);
        *(LAS v4u*)(lds + LRU_UC + (tid >> 3) * LRU_RS + c8 * 16) = pk;
        LAS f32x4* uf = (LAS f32x4*)(lds + LRU_UCF + (tid >> 3) * 256 + c8 * 32); uf[0] = o0; uf[1] = o1;
    }
    __syncthreads();
    if (I.wave < 2) {
        f32x16 a, bt, la_; lru_gates(C, 0, ct, lane, lds, a, bt, la_);
#pragma unroll
        for (int e = 0; e < 16; ++e) { const int sb = 32 * rq + crow(e, hi); const float h = a[e] * h0[e] + bt[e];
            A->out[O_HS + (size_t)(l * MS + sb) * DMAIN + chn] = h; z[(size_t)(MP + sb) * DCAT + chn] = (bf16)f2bf(h * bf2f(gz[e])); }
    }
    __syncthreads();
}
constexpr int SM_SC = 0, SM_RED = 2048;
struct SmemAddr { const f32x4* kp; const f32x4* vp; const bf16* qp; const bf16* gp; bf16* zp; };
__device__ __forceinline__ SmemAddr smem_addr(ArgsP A, int l, int pair, int w, int half, int ck) {
    const int sb = pair >> 2, mh = pair & 3; SmemAddr R;
    const size_t base = (((size_t)(l * MS + sb) * NMEM) * MEMH + mh) * MEMHD + (size_t)(32 * w + half) * (MEMH * MEMHD);
    R.kp = (const f32x4*)(A->in[I_CMK] + base) + ck; R.vp = (const f32x4*)(A->in[I_CMV] + base) + ck;
    const bf16* prow = (const bf16*)(A->ws + WS_PROJ) + (size_t)(MP + sb) * DIN;
    R.qp = prow + 2048 + mh * 128; R.gp = prow + 2560 + mh * 128; R.zp = (bf16*)(A->ws + WS_Z) + (size_t)(MP + sb) * DCAT + DMAIN + mh * 128;
    return R;
}
__device__ __forceinline__ f32x4 smem_q(const SmemAddr& R, int ck) {
    const unsigned long long qq = *(const unsigned long long*)(R.qp + 4 * ck); const unsigned lo = (unsigned)qq, hi = (unsigned)(qq >> 32);
    return (f32x4){__builtin_bit_cast(float, lo << 16), __builtin_bit_cast(float, lo & 0xffff0000u), __builtin_bit_cast(float, hi << 16), __builtin_bit_cast(float, hi & 0xffff0000u)};
}
#define SMEM_LOAD16(dst, src) do { _Pragma("unroll") for (int i = 0; i < 16; ++i) dst[i] = __builtin_nontemporal_load((src) + (size_t)i * (2 * MEMH * MEMHD / 4)); } while (0)
__device__ __forceinline__ void smem_scores(const f32x4 (&kf)[16], const f32x4 qv, LAS float* sc, int w, int half, int ck) {
#pragma unroll
    for (int i = 0; i < 16; ++i) {
        float s = (kf[i][0] * qv[0] + kf[i][1] * qv[1]) + (kf[i][2] * qv[2] + kf[i][3] * qv[3]);
        s += __shfl_xor(s, 1); s += __shfl_xor(s, 2); s += __shfl_xor(s, 4); s += __shfl_xor(s, 8); s += __shfl_xor(s, 16);
        if (ck == 0) sc[32 * w + 2 * i + half] = s;
    }
}
__device__ __forceinline__ void smem_pv(const f32x4 (&vf)[16], const LAS float* sc, LAS float* red, int w, int half, int ck, int lane) {
    float mx, inv;
    { const float s0 = sc[lane], s1 = sc[lane + 64], s2 = sc[lane + 128], s3 = sc[lane + 192];
      mx = wave_max(fmaxf(fmaxf(s0, s1), fmaxf(s2, s3)));
      const float e = (__builtin_amdgcn_exp2f(s0 - mx) + __builtin_amdgcn_exp2f(s1 - mx)) + (__builtin_amdgcn_exp2f(s2 - mx) + __builtin_amdgcn_exp2f(s3 - mx));
      inv = 1.0f / wave_sum(e); }
    f32x4 acc = {0.f, 0.f, 0.f, 0.f};
#pragma unroll
    for (int i = 0; i < 16; ++i) { const float p = __builtin_amdgcn_exp2f(sc[32 * w + 2 * i + half] - mx) * inv; acc += vf[i] * p; }
#pragma unroll
    for (int j = 0; j < 4; ++j) acc[j] += __shfl_xor(acc[j], 32);
    if (half == 0) *(LAS f32x4*)(red + w * 128 + 4 * ck) = acc;
}
__device__ __forceinline__ void smem_out(const SmemAddr& R, const LAS float* red, int tid) {
    if (tid < 128) { float o = 0.f;
#pragma unroll
        for (int ww = 0; ww < 8; ++ww) o += red[ww * 128 + tid];
        R.zp[tid] = (bf16)f2bf(o * bf2f(R.gp[tid])); }
}
__device__ __forceinline__ void smem_two(ArgsP A, const Ids& I, int l, int pairA, int pairB, LAS unsigned char* lds) {
    int tid = I.tid; asm volatile("" : "+v"(tid));
    const int lane = tid & 63, half = lane >> 5, ck = lane & 31, w = I.wave;
    LAS float* sc = (LAS float*)(lds + SM_SC); LAS float* red = (LAS float*)(lds + SM_RED);
    const SmemAddr RA = smem_addr(A, l, pairA, w, half, ck), RB = smem_addr(A, l, pairB, w, half, ck);
    const f32x4 qa = smem_q(RA, ck), qb = smem_q(RB, ck);
    __builtin_amdgcn_sched_barrier(0);
    f32x4 kf[16], vf[16];
    SMEM_LOAD16(kf, RA.kp); SMEM_LOAD16(vf, RA.vp);
    __builtin_amdgcn_sched_barrier(0);
    smem_scores(kf, qa, sc, w, half, ck);
    __builtin_amdgcn_sched_barrier(0);
    SMEM_LOAD16(kf, RB.kp);
    __builtin_amdgcn_sched_barrier(0);
    __syncthreads();
    smem_pv(vf, sc, red, w, half, ck, lane);
    __builtin_amdgcn_sched_barrier(0);
    SMEM_LOAD16(vf, RB.vp);
    __builtin_amdgcn_sched_barrier(0);
    __syncthreads();
    smem_out(RA, red, tid);
    smem_scores(kf, qb, sc + 256, w, half, ck);
    __syncthreads();
    smem_pv(vf, sc + 256, red, w, half, ck, lane);
    __syncthreads();
    smem_out(RB, red, tid);
    __syncthreads();
}
__device__ __forceinline__ void sswa_task(ArgsP A, int l, int task, int lane) {
    const int sb = task >> 4, h = task & 15, kvh = h >> 3, grp = lane >> 4, c = lane & 15;
    const bf16* proj = (const bf16*)(A->ws + WS_PROJ); bf16* z = (bf16*)(A->ws + WS_Z);
    const size_t r = (size_t)MP + sb;
    const int p0 = c < 8 ? 8 * c : 8 * (c - 8) + 4;
    f32x4 qv, knew, vnew;
    { const unsigned long long qq = *(const unsigned long long*)(proj + r * DIN + h * 64 + p0); const unsigned lo = (unsigned)qq, hi = (unsigned)(qq >> 32);
      qv = (f32x4){__builtin_bit_cast(float, lo << 16), __builtin_bit_cast(float, lo & 0xffff0000u), __builtin_bit_cast(float, hi << 16), __builtin_bit_cast(float, hi & 0xffff0000u)}; }
    { const unsigned long long kk = *(const unsigned long long*)((const bf16*)(A->ws + WS_KB) + r * 128 + kvh * 64 + p0); const unsigned lo = (unsigned)kk, hi = (unsigned)(kk >> 32);
      knew = (f32x4){__builtin_bit_cast(float, lo << 16), __builtin_bit_cast(float, lo & 0xffff0000u), __builtin_bit_cast(float, hi << 16), __builtin_bit_cast(float, hi & 0xffff0000u)}; }
    { const unsigned long long vv = *(const unsigned long long*)((const bf16*)(A->ws + WS_VB) + r * 128 + kvh * 64 + 4 * c); const unsigned lo = (unsigned)vv, hi = (unsigned)(vv >> 32);
      vnew = (f32x4){__builtin_bit_cast(float, lo << 16), __builtin_bit_cast(float, lo & 0xffff0000u), __builtin_bit_cast(float, hi << 16), __builtin_bit_cast(float, hi & 0xffff0000u)}; }
    const float sink2 = A->in[I_SINKS][(l - N_A) * NHEADS + h] * LOG2E;
    const f32x4* kp = (const f32x4*)(A->in[I_CWK] + ((size_t)(sb * WIN + grp) * NKV + kvh) * HD) + c;
    const f32x4* vp = (const f32x4*)(A->in[I_CWV] + ((size_t)(sb * WIN + grp) * NKV + kvh) * HD) + c;
    __builtin_amdgcn_sched_barrier(0);
    float s[32];
    { f32x4 kk[32];
#pragma unroll
      for (int i = 0; i < 32; ++i) kk[i] = __builtin_nontemporal_load(kp + (size_t)i * (4 * NKV * HD / 4));
      __builtin_amdgcn_sched_barrier(0);
#pragma unroll
      for (int i = 0; i < 32; ++i) { float t = (kk[i][0] * qv[0] + kk[i][1] * qv[1]) + (kk[i][2] * qv[2] + kk[i][3] * qv[3]);
          t += __shfl_xor(t, 1); t += __shfl_xor(t, 2); t += __shfl_xor(t, 4); t += __shfl_xor(t, 8);
          s[i] = t; } }
    if (grp == 0) s[0] = -1.0e30f;
    float sn = (knew[0] * qv[0] + knew[1] * qv[1]) + (knew[2] * qv[2] + knew[3] * qv[3]);
    sn += __shfl_xor(sn, 1); sn += __shfl_xor(sn, 2); sn += __shfl_xor(sn, 4); sn += __shfl_xor(sn, 8);
    float mx = fmaxf(sn, sink2);
#pragma unroll
    for (int i = 0; i < 32; ++i) mx = fmaxf(mx, s[i]);
    mx = fmaxf(mx, __shfl_xor(mx, 16)); mx = fmaxf(mx, __shfl_xor(mx, 32));
    float sum = 0.f; f32x4 acc = {0.f, 0.f, 0.f, 0.f};
#pragma unroll
    for (int hb = 0; hb < 2; ++hb) { f32x4 vv[16];
#pragma unroll
        for (int i = 0; i < 16; ++i) vv[i] = __builtin_nontemporal_load(vp + (size_t)(16 * hb + i) * (4 * NKV * HD / 4));
        __builtin_amdgcn_sched_barrier(0);
#pragma unroll
        for (int i = 0; i < 16; ++i) { const float p = __builtin_amdgcn_exp2f(s[16 * hb + i] - mx); sum += p; acc += vv[i] * p; }
        __builtin_amdgcn_sched_barrier(0); }
    sum += __shfl_xor(sum, 16); sum += __shfl_xor(sum, 32);
#pragma unroll
    for (int j = 0; j < 4; ++j) { acc[j] += __shfl_xor(acc[j], 16); acc[j] += __shfl_xor(acc[j], 32); }
    const float pn = __builtin_amdgcn_exp2f(sn - mx);
    const float den = sum + pn + __builtin_amdgcn_exp2f(sink2 - mx);
    acc += vnew * pn;
    if (lane < 16) { const float inv = 1.0f / den;
        const unsigned long long gg = *(const unsigned long long*)(proj + r * DIN + DMAIN + h * 64 + 4 * c); const unsigned lo = (unsigned)gg, hi = (unsigned)(gg >> 32);
        const unsigned o0 = pk2(acc[0] * inv * __builtin_bit_cast(float, lo << 16), acc[1] * inv * __builtin_bit_cast(float, lo & 0xffff0000u));
        const unsigned o1 = pk2(acc[2] * inv * __builtin_bit_cast(float, hi << 16), acc[3] * inv * __builtin_bit_cast(float, hi & 0xffff0000u));
        *(unsigned long long*)(z + r * DCAT + h * 64 + 4 * c) = (unsigned long long)o0 | ((unsigned long long)o1 << 32); }
}
template <int K> __device__ __forceinline__ f32x4 skinny_core(const bf16* a0, const bf16* b0, int wave, int lane, LAS unsigned char* lds) {
    constexpr int KS = K / 8 / 32;
    const int rl = lane & 15, kq = lane >> 4, kb = wave * (K / 8) + 8 * kq;
    bf16x8 af[4][KS], bfr[2][KS];
#pragma unroll
    for (int cg = 0; cg < 2; ++cg)
#pragma unroll
        for (int ks = 0; ks < KS; ++ks) bfr[cg][ks] = *(const bf16x8*)(b0 + (size_t)(16 * cg + rl) * K + kb + 32 * ks);
#pragma unroll
    for (int rg = 0; rg < 4; ++rg)
#pragma unroll
        for (int ks = 0; ks < KS; ++ks) af[rg][ks] = *(const bf16x8*)(a0 + (size_t)(16 * rg + rl) * K + kb + 32 * ks);
    __builtin_amdgcn_sched_barrier(0);
    LAS f32x4* part = (LAS f32x4*)lds;
#pragma unroll
    for (int rg = 0; rg < 4; ++rg)
#pragma unroll
        for (int cg = 0; cg < 2; ++cg) { f32x4 acc = {0.f, 0.f, 0.f, 0.f};
#pragma unroll
            for (int ks = 0; ks < KS; ++ks) acc = __builtin_amdgcn_mfma_f32_16x16x32_bf16(bfr[cg][ks], af[rg][ks], acc, 0, 0, 0);
            part[(wave * 8 + rg * 2 + cg) * 64 + lane] = acc; }
    __syncthreads();
    f32x4 r = part[(0 * 8 + wave) * 64 + lane];
#pragma unroll
    for (int ws = 1; ws < 8; ++ws) r += part[(ws * 8 + wave) * 64 + lane];
    __syncthreads();
    return r;
}
__device__ __forceinline__ void skinny_in_item(ArgsP A, const Ids& I, int l, int item, LAS unsigned char* lds) {
    unsigned char* ws = A->ws;
    int tid = I.tid; asm volatile("" : "+v"(tid));
    const int lane = tid & 63, rl = lane & 15, kq = lane >> 4, rh = item & 1, c0 = (item >> 1) * 32;
    const bf16* xb = (const bf16*)(ws + WS_XB); const bf16* wt = (const bf16*)(ws + WS_WIN + l * WIN_STRIDE);
    const int rg = I.wave >> 1, cg = I.wave & 1;
    const int r = MP + 64 * rh + 16 * rg + rl, c = c0 + 16 * cg + 4 * kq, sb = r - MP;
    const int kind = c0 < 1024 ? (l >= N_A ? 1 : 0) : c0 < 2048 ? 2 : c0 < 2560 ? 3 : c0 < 3072 ? 2 : c0 < 3200 ? 4 : 5;
    const float rsq_ = ((const float*)(ws + WS_ROWSQ))[(size_t)l * MPAD + r];
    f32x4 cs = {1.f, 1.f, 1.f, 1.f}, sn = {0.f, 0.f, 0.f, 0.f};
    if (kind == 1 || kind == 4) { const float* rp = (const float*)(ws + WS_ROPE) + (size_t)SEQ * 64 + 4 * ((c & 63) >> 3); cs = *(const f32x4*)rp; sn = *(const f32x4*)(rp + 32); }
    f32x4 v = skinny_core<DM>(xb + (size_t)(MP + 64 * rh) * DM, wt + (size_t)c0 * DM, I.wave, lane, lds);
    const float rs = __builtin_amdgcn_rsqf(rsq_ * (1.0f / 1024.0f) + EPS);
    v = v * rs;
    if (kind == 1 || kind == 4) {
        const int p = c & 63, n = (p >> 2) & 1, g = p >> 3;
        f32x4 o;
#pragma unroll
        for (int i = 0; i < 4; ++i) o[i] = __shfl_xor(v[i], 16);
        v = n == 0 ? v * cs - o * sn : v * cs + o * sn;
        if (kind == 1) v = v * QSCALE;
        else { *(f32x4*)(A->out + O_WKS + ((size_t)(sb * WIN + (WIN - 1)) * 2 + ((c - 3072) >> 6)) * 64 + 32 * n + 4 * g) = v; }
    } else if (kind == 2) {
#pragma unroll
        for (int i = 0; i < 4; ++i) v[i] = pg8::silu_f(v[i]);
    } else if (kind == 3) v = v * MSCALE;
    else if (kind == 5) *(f32x4*)(A->out + O_WVS + (size_t)(sb * WIN + (WIN - 1)) * 128 + (c - 3200)) = v;
    const unsigned long long w = (unsigned long long)pk2(v[0], v[1]) | ((unsigned long long)pk2(v[2], v[3]) << 32);
    bf16* dst = kind == 4 ? (bf16*)(ws + WS_KB) + (size_t)r * 128 + (c - 3072) : kind == 5 ? (bf16*)(ws + WS_VB) + (size_t)r * 128 + (c - 3200) : (bf16*)(ws + WS_PROJ) + (size_t)r * DIN + c;
    *(unsigned long long*)dst = w;
}
__device__ __forceinline__ void skinny_out_item(ArgsP A, const Ids& I, int l, int item, LAS unsigned char* lds) {
    unsigned char* ws = A->ws;
    int tid = I.tid; asm volatile("" : "+v"(tid));
    const int lane = tid & 63, rl = lane & 15, kq = lane >> 4, rh = item & 1, c0 = (item >> 1) * 32;
    const bf16* zb = (const bf16*)(ws + WS_Z); const bf16* wt = (const bf16*)(ws + WS_WOUT + l * WOUT_STRIDE);
    const int rg = I.wave >> 1, cg = I.wave & 1;
    const int r = MP + 64 * rh + 16 * rg + rl, c = c0 + 16 * cg + 4 * kq;
    bf16* xbp = (bf16*)(ws + WS_XB) + (size_t)r * DM + c;
    const unsigned long long xw_ = *(const unsigned long long*)xbp;
    const f32x4 acc = skinny_core<DCAT>(zb + (size_t)(MP + 64 * rh) * DCAT, wt + (size_t)c0 * DCAT, I.wave, lane, lds);
    f32x4 xo;
    { const unsigned long long w = xw_; const unsigned lo = (unsigned)w, hi = (unsigned)(w >> 32);
      xo = (f32x4){__builtin_bit_cast(float, lo << 16), __builtin_bit_cast(float, lo & 0xffff0000u), __builtin_bit_cast(float, hi << 16), __builtin_bit_cast(float, hi & 0xffff0000u)}; }
    const f32x4 xn = xo + acc;
    *(unsigned long long*)xbp = (unsigned long long)pk2(xn[0], xn[1]) | ((unsigned long long)pk2(xn[2], xn[3]) << 32);
    float ss = (xn[0] * xn[0] + xn[1] * xn[1]) + (xn[2] * xn[2] + xn[3] * xn[3]);
    ss += __shfl_xor(ss, 16); ss += __shfl_xor(ss, 32);
    if (kq == 0) atomicAdd((float*)(ws + WS_ROWSQ) + (size_t)(l + 1) * MPAD + r, ss);
}
#ifndef MK_PER_PHASE
#define MK_PER_PHASE 0
#endif
constexpr int NPHASES = 1 + N_A * 3 + (DEPTH - N_A) * 3;

enum { K_P0 = 0, K_MEM, K_IN, K_LRU1, K_LRU2  , K_ATT, K_OUT, K_FINAL };
__device__ __forceinline__ void decode_phase(int ph, int& kind, int& l) {
    l = 0;
    if (ph == 0) { kind = K_P0; return; }
    int q = ph - 1;
    if (q < N_A * 3) { l = q / 3; const int k = q - l * 3; kind = k == 0 ? K_IN : k == 1 ? K_LRU1 : K_OUT; return; }
    q -= N_A * 3;
    if (q < (DEPTH - N_A) * 3) { const int j = q / 3, k = q - j * 3; l = N_A + j; kind = k == 0 ? K_IN : k == 1 ? K_ATT : K_OUT; return; }
    kind = K_FINAL;
}

__global__ void __launch_bounds__(NWAVES * 64, 2) mk_fwd(Args args) {
    extern __shared__ __attribute__((aligned(16))) unsigned char lds_raw[];
    LAS unsigned char* lds = (LAS unsigned char*)lds_raw;
    for (int u = threadIdx.x; u < (LDS_BYTES - LDSCTL_OFF) / 4; u += NWAVES * 64) ((LAS unsigned*)(lds + LDSCTL_OFF))[u] = 0u;
    __syncthreads();
    XcdBarrier bar; bar.bar = (unsigned*)(args.ws + WS_CTL) + CW_BAR; bar.x = 0; bar.st = nullptr;
    if (!MK_PER_PHASE) bar = xcd_barrier_post((unsigned*)(args.ws + WS_CTL) + CW_BAR, (volatile LAS unsigned*)(lds + MISC_OFF) + 8);
    const int lo = args.ph_lo, hi = args.ph_hi;
#ifdef PROF_MASK
    unsigned long long prof_acc = 0ull, prof_t0 = __builtin_amdgcn_s_memrealtime();
#define PROF_MARK(kind_) do { const unsigned long long t_ = __builtin_amdgcn_s_memrealtime(); if ((PROF_MASK >> (kind_)) & 1) prof_acc += t_ - prof_t0; prof_t0 = t_; } while (0)
#else
#define PROF_MARK(kind_) do {} while (0)
#endif
    if (lo == 0) {
        const ArgsP A = get_args(); unsigned char* ws = A->ws;
        int G = gridDim.x, bx = blockIdx.x; asm volatile("" : "+s"(G), "+s"(bx));
        wlist_run<false>(A, lds, bx, G);
        if (bx < 32) { const Ids I = make_ids(); p0_rows(A, MPAD, MPAD + 512, bx * NWAVES + I.wave, 32 * NWAVES); }
        unsigned* c256 = (unsigned*)(ws + WS_CTL) + CW_FIN + 64 * 72;
        asm volatile("s_waitcnt vmcnt(0)" ::: "memory"); __syncthreads();
        if (threadIdx.x == 0) { __builtin_amdgcn_fence(__ATOMIC_RELEASE, "agent"); asm volatile("s_waitcnt vmcnt(0)" ::: "memory"); __hip_atomic_fetch_add(c256, 1u, __ATOMIC_RELAXED, __HIP_MEMORY_SCOPE_AGENT); }
        if (bx < 32) {
            if (threadIdx.x < 64) { unsigned spins = 0;
                while ((unsigned)__builtin_amdgcn_readfirstlane(__hip_atomic_load(c256, __ATOMIC_RELAXED, __HIP_MEMORY_SCOPE_AGENT)) < (unsigned)G && ++spins < (1u << 22)) __builtin_amdgcn_s_sleep(2);
                __builtin_amdgcn_fence(__ATOMIC_ACQUIRE, "agent"); asm volatile("s_waitcnt vmcnt(0)" ::: "memory"); }
            __syncthreads();
            pg8::Gemm g{(const bf16*)(ws + WS_MEMB), (const bf16*)(ws + WS_WMEM), 512, DEPTH * DM, DM}; pg8::StaticOrder S; S.init(512, DEPTH * DM, G, bx);
            pg8::EpiMem E{A->out + O_MK, A->out + O_MV, (bf16*)(ws + WS_MKB), (bf16*)(ws + WS_MVB), (const float*)(ws + WS_RSQM)};
            pg8::gemm_phase<pg8::EpiMem, pg8::StaticOrder, true, true>(lds + RING_OFF, g, S, E); PROF_MARK(19);
        } else {
            wlist_run<true>(A, lds, bx - 32, G - 32); PROF_MARK(20);
            int tid = threadIdx.x; asm volatile("" : "+v"(tid)); const int wv = __builtin_amdgcn_readfirstlane(tid >> 6);
            p0_rows(A, 0, MPAD, (bx - 32) * NWAVES + wv, (G - 32) * NWAVES);
            p0_misc(A, (bx - 32) * (NWAVES * 64) + tid, (G - 32) * (NWAVES * 64));
            p0_rope(A, (bx - 32) * (NWAVES * 64) + tid, (G - 32) * (NWAVES * 64)); PROF_MARK(21);
        }
        if (!MK_PER_PHASE && 1 < hi) xcd_barrier(bar); PROF_MARK(K_P0); }
#pragma unroll 1
    for (int ph = (lo > 1 ? lo : 1); ph < hi; ++ph) {
        const ArgsP A = get_args();
        unsigned char* ws = A->ws;
        int G = gridDim.x, bx = blockIdx.x; asm volatile("" : "+s"(G), "+s"(bx));
        int kind, l; decode_phase(ph, kind, l);
        switch (kind) {
        case K_IN: {
            const int N = (l == N_A) ? DIN + 256 : DIN;
            pg8::Gemm g{(const bf16*)(ws + WS_XB), (const bf16*)(ws + WS_WIN + l * WIN_STRIDE), MP, N, DM}; pg8::StaticOrder S; S.init(MP, N, G, bx);
            pg8::EpiIn E{(bf16*)(ws + WS_PROJ), (bf16*)(ws + WS_KB), (bf16*)(ws + WS_VB), (const float*)(ws + WS_ROWSQ) + (size_t)l * MPAD, (const float*)(ws + WS_ROPE), A->out, l >= N_A ? 1 : 0};
            const int skb = (l == N_A) ? 64 : 0, nown = (l == N_A) ? G - 64 : G;
            { const Ids I = make_ids(); const int it = (l == N_A) ? bx - skb : (I.gw >> 3); if (it >= 0 && it < N / 16 && (it & 1)) skinny_in_item(A, I, l, it, lds); }
            pg8::gemm_phase<pg8::EpiIn, pg8::StaticOrder, true, true>(lds + RING_OFF, g, S, E); PROF_MARK(8);
            { const Ids I = make_ids(); const int it = (l == N_A) ? bx - skb : (I.gw >> 3); if (it >= 0 && it < N / 16 && !(it & 1)) skinny_in_item(A, I, l, it, lds);
              if (it >= 0 && it + nown < N / 16) skinny_in_item(A, I, l, it + nown, lds); } PROF_MARK(9);
        } break;
        case K_LRU1: {
            const Ids I = make_ids();
            lru_prompt_pass<1>(A, I, l, lds); PROF_MARK(12);
            for (int u = I.gw >> 3; u < 256; u += G) mem_unit(A, I, l, u, lds); PROF_MARK(13);
            smem_two(A, I, l, I.gw >> 3, (I.gw >> 3) + 256, lds); PROF_MARK(14);
            lru_prompt_pass2(A, I, l, lds); PROF_MARK(15);
            for (int u = I.gw >> 3; u < 64; u += G) lru_sample_item(A, I, l, u, lds); PROF_MARK(16);
        } break;
        case K_ATT: {
            const Ids I = make_ids();
            smem_two(A, I, l, I.gw >> 3, (I.gw >> 3) + 256, lds); PROF_MARK(14);
            for (int u = I.gw >> 3; u < 256; u += G) swa_unit(A, I, l, u, lds); PROF_MARK(17);
            for (int u = I.gw >> 3; u < 256; u += G) mem_unit(A, I, l, u, lds); PROF_MARK(13);
            for (int t = I.gw; t < MS * NHEADS; t += I.NGW) sswa_task(A, l, t, I.lane); PROF_MARK(18);
        } break;
        case K_OUT: {
            pg8::Gemm g{(const bf16*)(ws + WS_Z), (const bf16*)(ws + WS_WOUT + l * WOUT_STRIDE), MP, DM, DCAT}; pg8::StaticOrder S; S.init(MP, DM, G, bx);
            if (l < DEPTH - 1) {
                pg8::EpiOut E{nullptr, (bf16*)(ws + WS_XB), (float*)(ws + WS_ROWSQ) + (size_t)(l + 1) * MPAD};
                { const Ids I = make_ids(); const int it = I.gw >> 3; if (it < DM / 16 && (it & 1)) skinny_out_item(A, I, l, it, lds); }
                pg8::gemm_phase<pg8::EpiOut, pg8::StaticOrder, true, true>(lds + RING_OFF, g, S, E); PROF_MARK(10);
                { const Ids I = make_ids(); const int it = I.gw >> 3; if (it < DM / 16 && !(it & 1)) skinny_out_item(A, I, l, it, lds); } PROF_MARK(11);
            } else {
                unsigned* fcnt = (unsigned*)(ws + WS_CTL) + CW_FIN;
                const Ids I = make_ids(); const int vcu = I.gw >> 3;
                if (vcu < DM / 16) { skinny_out_item(A, I, l, vcu, lds);
                    asm volatile("s_waitcnt vmcnt(0)" ::: "memory"); __syncthreads();
                    if (I.tid == 0) { __builtin_amdgcn_fence(__ATOMIC_RELEASE, "agent"); asm volatile("s_waitcnt vmcnt(0)" ::: "memory"); __hip_atomic_fetch_add(fcnt + 64 * 64, 1u, __ATOMIC_RELAXED, __HIP_MEMORY_SCOPE_AGENT); } }
                pg8::EpiOutFinal E{A->out + O_YP, (const bf16*)(ws + WS_XB), A->in[I_FINALG], (float*)(ws + WS_XCHG), fcnt};
                pg8::gemm_phase<pg8::EpiOutFinal, pg8::StaticOrder, false, true>(lds + RING_OFF, g, S, E); PROF_MARK(10);
                if (vcu >= 64 && vcu < 80) {
                    if (I.wave == 0) { unsigned spins = 0;
                        while ((unsigned)__builtin_amdgcn_readfirstlane(__hip_atomic_load(fcnt + 64 * 64, __ATOMIC_RELAXED, __HIP_MEMORY_SCOPE_AGENT)) < (unsigned)(DM / 16) && ++spins < (1u << 22)) __builtin_amdgcn_s_sleep(2);
                        __builtin_amdgcn_fence(__ATOMIC_ACQUIRE, "agent"); asm volatile("s_waitcnt vmcnt(0)" ::: "memory"); }
                    __syncthreads();
                    final_norm_row(A, MP + 8 * (vcu - 64) + I.wave, I.lane);
                } PROF_MARK(11);
            }
        } break;
        default: break;
        }
        if (!MK_PER_PHASE && ph + 1 < hi) xcd_barrier(bar);
        PROF_MARK(kind);
    }
#ifdef PROF_MASK
    __syncthreads();
    if (blockIdx.x == 0 && threadIdx.x == 0) { const unsigned long long t0_ = __builtin_amdgcn_s_memrealtime(); while (__builtin_amdgcn_s_memrealtime() - t0_ < 8ull * prof_acc) __builtin_amdgcn_s_sleep(8); }
#endif
}

extern "C" void kernel_launch(void* const* d_in, const int* in_sizes, int n_in, void* d_out, int out_size, void* d_ws, size_t ws_size, hipStream_t stream) {
    static int grid = 0;
    if (grid == 0) {
        if (n_in != N_IN || (size_t)out_size != O_END || ws_size < WS_END) { fprintf(stderr, "kernel_launch: unexpected shapes (n_in %d out %d ws %zu); nothing launched\n", n_in, out_size, ws_size); grid = -1; return; }
        int dev = 0, cus = 0, per_cu = 0;
        if (hipGetDevice(&dev) != hipSuccess || hipDeviceGetAttribute(&cus, hipDeviceAttributeMultiprocessorCount, dev) != hipSuccess) { grid = -1; return; }
        if (hipFuncSetAttribute((const void*)mk_fwd, hipFuncAttributeMaxDynamicSharedMemorySize, LDS_BYTES) != hipSuccess) { fprintf(stderr, "kernel_launch: hipFuncSetAttribute failed\n"); grid = -1; return; }
        if (hipOccupancyMaxActiveBlocksPerMultiprocessor(&per_cu, (const void*)mk_fwd, NWAVES * 64, LDS_BYTES) != hipSuccess || per_cu < 1) { fprintf(stderr, "kernel_launch: occupancy query reports %d\n", per_cu); }
        (void)hipGetLastError();
        if (cus != 256) { fprintf(stderr, "kernel_launch: built for a 256-CU device (got %d)\n", cus); grid = -1; return; }
        grid = cus;
    }
    if (grid < 0) return;
    if (hipMemsetAsync((char*)d_ws + WS_CTL, 0, CTL_ZERO_BYTES, stream) != hipSuccess) return;
    Args a{};
    for (int i = 0; i < N_IN; ++i) a.in[i] = (const float*)d_in[i];
    a.out = (float*)d_out; a.ws = (unsigned char*)d_ws;
#if MK_PER_PHASE
    for (int p = 0; p < NPHASES; ++p) { a.ph_lo = p; a.ph_hi = p + 1; hipLaunchKernelGGL(mk_fwd, dim3(grid), dim3(NWAVES * 64), LDS_BYTES, stream, a); }
#else
    a.ph_lo = 0; a.ph_hi = NPHASES; hipLaunchKernelGGL(mk_fwd, dim3(grid), dim3(NWAVES * 64), LDS_BYTES, stream, a);
#endif
}
```

```cpp
#include <hip/hip_runtime.h>
#include <cstdio>
#include <cstdint>
constexpr int DM = 1024;
constexpr int SEQ = 8192, NB = 2;
constexpr int MP = NB * SEQ;
constexpr int MS = 128;
constexpr int MV = MP + MS;
constexpr int MPAD = 16640;
constexpr int DEPTH = 4, N_A = 2;
constexpr int DIN = 3072, DCAT = 1536, DMAIN = 1024, DMEMW = 512;
constexpr int NMEM = 256, MEMH = 4, MEMHD = 128;
constexpr int NHEADS = 16, HD = 64, NKV = 2, WIN = 128;
constexpr float EPS = 1e-6f;
constexpr float LOG2E = 1.4426950408889634f;
constexpr float QSCALE = 0.125f * LOG2E;
constexpr float MSCALE = 0.08838834764831845f * LOG2E;
constexpr size_t O_YP = 0, O_YS = 16777216, O_MK = 16908288, O_MV = 17956864, O_HP = 19005440, O_CP = 19009536, O_WKP = 19021824, O_WVP = 19054592,
                 O_HS = 19087360, O_CS = 19349504, O_WKS = 20135936, O_WVS = 22233088, O_END = 24330240;
#define MK_PER_PHASE 0
namespace pg8 {
#define PG8_LAS __attribute__((address_space(3)))
typedef unsigned short bf16_t;
typedef short bf16x8 __attribute__((ext_vector_type(8)));
typedef float f32x4 __attribute__((ext_vector_type(4)));
typedef unsigned u32x4 __attribute__((ext_vector_type(4)));
constexpr int BM = 256, BK = 64, HALF = 128, HTB = HALF * BK * 2  , STAGE_BYTES = 8 * HTB, NXCD = 8, WGM = 8;

__host__ __device__ __forceinline__ int lds_byte(int r, int c) { const int st = (r >> 4) * 2 + (c >> 5), rr = r & 15, cc = c & 31, ob = rr * 64 + cc * 2; return st * 1024 + (ob ^ (((ob >> 9) & 1) << 5)); }
__host__ __device__ __forceinline__ void stage_rc(int b, int& R, int& C) { const int st = b / 1024, sb = b % 1024, swz = sb ^ (((sb >> 9) & 1) << 5); R = (st >> 1) * 16 + swz / 64; C = (st & 1) * 32 + (swz % 64) / 2; }
__host__ __device__ __forceinline__ int perm32(int rho) { const int n = rho >> 4, i = rho & 15; return 8 * (i >> 2) + 4 * n + (i & 3); }

struct Unit { int pm, pn; };
struct Gemm { const bf16_t* A; const bf16_t* Bt; int M, N, K; };

struct StaticOrder {
    int nM, nN, nwg, G, c;
    __host__ __device__ void init(int M, int N, int G_, int c_) { nM = M / BM; nN = N / BM; nwg = nM * nN; G = G_; c = c_; }
    __host__ __device__ bool next(int i, Unit& u) const {
        const long L = (long)i * G + c; if (L >= nwg) return false;
        int wgid = (int)L; { const int q = nwg / NXCD, r = nwg % NXCD, xcd = wgid % NXCD, off = wgid / NXCD; wgid = (xcd < r ? xcd * (q + 1) : r * (q + 1) + (xcd - r) * q) + off; }
        const int nig = WGM * nN, gid = wgid / nig, fm = gid * WGM, gsz = (nM - fm) < WGM ? (nM - fm) : WGM;
        u.pm = fm + ((wgid % nig) % gsz); u.pn = (wgid % nig) / gsz; return true;
    }
    __device__ __forceinline__ void a_ready(const Unit&) const {}
    __device__ __forceinline__ void done(const Unit&) const {}
};
__device__ __forceinline__ unsigned cvt_pk_bf16(float lo, float hi) { unsigned r; asm volatile("v_cvt_pk_bf16_f32 %0, %1, %2" : "=v"(r) : "v"(lo), "v"(hi)); return r; }
typedef float f32x2 __attribute__((ext_vector_type(2)));
typedef unsigned u32x2 __attribute__((ext_vector_type(2)));
__device__ __forceinline__ float silu_f(float g) { return g * __builtin_amdgcn_rcpf(1.0f + __builtin_amdgcn_exp2f(-g * LOG2E)); }
__device__ __forceinline__ u32x4 pack8(const f32x4 a, const f32x4 b) { u32x4 w; w.x = cvt_pk_bf16(a[0], a[1]); w.y = cvt_pk_bf16(a[2], a[3]); w.z = cvt_pk_bf16(b[0], b[1]); w.w = cvt_pk_bf16(b[2], b[3]); return w; }
struct EpiIn {
    static constexpr bool PERM = true, AFTER_DRAIN = false;
    bf16_t* proj; bf16_t* kb; bf16_t* vb; const float* rowsq; const float* rope; float* out; int att;
    template <int KIND> __device__ __forceinline__ void run(const f32x4 (&acc)[2][2][4][2], const Unit& u, int wr, int wc, int fr, int fq) const {
        const int pn = u.pn, g = 4 * (wc & 1) + fq, colb = wc * 32 + 8 * fq;
        const int rbase = u.pm * BM + wr * 64 + fr;
        float rsv[2][4];
#pragma unroll
        for (int ai = 0; ai < 2; ++ai)
#pragma unroll
            for (int m = 0; m < 4; ++m) rsv[ai][m] = rowsq[rbase + ai * HALF + m * 16];
        if (KIND == 0 || KIND == 2 || KIND == 3) {
#pragma unroll
            for (int ai = 0; ai < 2; ++ai)
#pragma unroll
                for (int m = 0; m < 4; ++m) { const int r = rbase + ai * HALF + m * 16;
                    const float rs = __builtin_amdgcn_rsqf(rsv[ai][m] * (1.0f / 1024.0f) + EPS) * (KIND == 3 ? MSCALE : 1.0f);
#pragma unroll
                    for (int bj = 0; bj < 2; ++bj) { f32x4 v0 = acc[ai][bj][m][0] * rs, v1 = acc[ai][bj][m][1] * rs;
                        if (KIND == 2) {
#pragma unroll
                            for (int i = 0; i < 4; ++i) { v0[i] = silu_f(v0[i]); v1[i] = silu_f(v1[i]); } }
                        *(u32x4*)(proj + (size_t)r * DIN + pn * BM + bj * HALF + colb) = pack8(v0, v1); } }
        } else if (KIND == 1) {
            f32x4 cs[4], sn[4]; u32x4 o0[4][2];
#pragma unroll
            for (int m = 0; m < 4; ++m) { const float* rp = rope + (size_t)((rbase + m * 16) & (SEQ - 1)) * 64 + 4 * g; cs[m] = *(const f32x4*)rp; sn[m] = *(const f32x4*)(rp + 32); }
#pragma unroll
            for (int m = 0; m < 4; ++m) { const float rs = __builtin_amdgcn_rsqf(rsv[0][m] * (1.0f / 1024.0f) + EPS) * QSCALE;
#pragma unroll
                for (int bj = 0; bj < 2; ++bj) { const f32x4 v0 = acc[0][bj][m][0] * rs, v1 = acc[0][bj][m][1] * rs; o0[m][bj] = pack8(v0 * cs[m] - v1 * sn[m], v1 * cs[m] + v0 * sn[m]); } }
            __builtin_amdgcn_sched_barrier(0);
#pragma unroll
            for (int m = 0; m < 4; ++m) { const float* rp = rope + (size_t)((rbase + HALF + m * 16) & (SEQ - 1)) * 64 + 4 * g; cs[m] = *(const f32x4*)rp; sn[m] = *(const f32x4*)(rp + 32); }
            __builtin_amdgcn_sched_barrier(0);
#pragma unroll
            for (int m = 0; m < 4; ++m)
#pragma unroll
                for (int bj = 0; bj < 2; ++bj) *(u32x4*)(proj + (size_t)(rbase + m * 16) * DIN + pn * BM + bj * HALF + colb) = o0[m][bj];
#pragma unroll
            for (int m = 0; m < 4; ++m) { const float rs = __builtin_amdgcn_rsqf(rsv[1][m] * (1.0f / 1024.0f) + EPS) * QSCALE;
#pragma unroll
                for (int bj = 0; bj < 2; ++bj) { const f32x4 v0 = acc[1][bj][m][0] * rs, v1 = acc[1][bj][m][1] * rs;
                    *(u32x4*)(proj + (size_t)(rbase + HALF + m * 16) * DIN + pn * BM + bj * HALF + colb) = pack8(v0 * cs[m] - v1 * sn[m], v1 * cs[m] + v0 * sn[m]); } }
        } else {
#pragma unroll
            for (int ai = 0; ai < 2; ++ai) {
                f32x4 cs[4], sn[4];
#pragma unroll
                for (int m = 0; m < 4; ++m) { const float* rp = rope + (size_t)((rbase + ai * HALF + m * 16) & (SEQ - 1)) * 64 + 4 * g; cs[m] = *(const f32x4*)rp; sn[m] = *(const f32x4*)(rp + 32); }
#pragma unroll
                for (int m = 0; m < 4; ++m) { const int r = rbase + ai * HALF + m * 16; const int t = r & (SEQ - 1);
                    const float rs = __builtin_amdgcn_rsqf(rsv[ai][m] * (1.0f / 1024.0f) + EPS);
                    { const f32x4 v0 = acc[ai][0][m][0] * rs, v1 = acc[ai][0][m][1] * rs; const f32x4 o0 = v0 * cs[m] - v1 * sn[m], o1 = v1 * cs[m] + v0 * sn[m];
                      *(u32x4*)(kb + (size_t)r * 128 + colb) = pack8(o0, o1);
                      if (t >= SEQ - WIN) { float* dst = out + O_WKP + ((size_t)((r >> 13) * WIN + (t - (SEQ - WIN))) * 2 + (wc >> 1)) * 64; *(f32x4*)(dst + 4 * g) = o0; *(f32x4*)(dst + 32 + 4 * g) = o1; } }
                    { const f32x4 v0 = acc[ai][1][m][0] * rs, v1 = acc[ai][1][m][1] * rs;
                      *(u32x4*)(vb + (size_t)r * 128 + colb) = pack8(v0, v1);
                      if (t >= SEQ - WIN) { float* dst = out + O_WVP + (size_t)((r >> 13) * WIN + (t - (SEQ - WIN))) * 128; *(f32x4*)(dst + colb) = v0; *(f32x4*)(dst + colb + 4) = v1; } } }
            }
        }
    }
    __device__ __forceinline__ void operator()(const f32x4 (&acc)[2][2][4][2], const Unit& u, int wr, int wc, int fr, int fq) const {
        asm volatile("" : "+v"(fr), "+v"(fq));
        const int pn = u.pn;
        if (pn < 4) { if (att) run<1>(acc, u, wr, wc, fr, fq); else run<0>(acc, u, wr, wc, fr, fq); }
        else if (pn < 8) run<2>(acc, u, wr, wc, fr, fq);
        else if (pn < 10) run<3>(acc, u, wr, wc, fr, fq);
        else if (pn < 12) run<2>(acc, u, wr, wc, fr, fq);
        else run<4>(acc, u, wr, wc, fr, fq);
    }
};
struct EpiOut {
    static constexpr bool PERM = true, AFTER_DRAIN = false;
    float* xf; bf16_t* xb; float* rowsq_next;
    __device__ __forceinline__ void operator()(const f32x4 (&acc)[2][2][4][2], const Unit& u, int wr, int wc, int fr, int fq) const {
        asm volatile("" : "+v"(fr), "+v"(fq));
        const int col0 = u.pn * BM + wc * 32 + 8 * fq, rbase = u.pm * BM + wr * 64 + fr;
        u32x4 xo[2][4][2];
#pragma unroll
        for (int ai = 0; ai < 2; ++ai)
#pragma unroll
            for (int m = 0; m < 4; ++m)
#pragma unroll
                for (int bj = 0; bj < 2; ++bj) xo[ai][m][bj] = *(const u32x4*)(xb + (size_t)(rbase + ai * HALF + m * 16) * DM + col0 + bj * HALF);
#pragma unroll
        for (int ai = 0; ai < 2; ++ai)
#pragma unroll
            for (int m = 0; m < 4; ++m) { const int r = rbase + ai * HALF + m * 16; float ss = 0.f;
#pragma unroll
                for (int bj = 0; bj < 2; ++bj) { const u32x4 wo = xo[ai][m][bj];
                    const f32x4 x0 = (f32x4){__builtin_bit_cast(float, wo.x << 16), __builtin_bit_cast(float, wo.x & 0xffff0000u), __builtin_bit_cast(float, wo.y << 16), __builtin_bit_cast(float, wo.y & 0xffff0000u)} + acc[ai][bj][m][0];
                    const f32x4 x1 = (f32x4){__builtin_bit_cast(float, wo.z << 16), __builtin_bit_cast(float, wo.z & 0xffff0000u), __builtin_bit_cast(float, wo.w << 16), __builtin_bit_cast(float, wo.w & 0xffff0000u)} + acc[ai][bj][m][1];
                    *(u32x4*)(xb + (size_t)r * DM + col0 + bj * HALF) = pack8(x0, x1);
                    ss += ((x0[0] * x0[0] + x0[1] * x0[1]) + (x0[2] * x0[2] + x0[3] * x0[3])) + ((x1[0] * x1[0] + x1[1] * x1[1]) + (x1[2] * x1[2] + x1[3] * x1[3])); }
                ss += __shfl_xor(ss, 16); ss += __shfl_xor(ss, 32);
                if (fq == 0) atomicAdd(rowsq_next + r, ss);
            }
    }
};
struct EpiOutFinal {
    static constexpr bool PERM = false, AFTER_DRAIN = true;
    float* y; const bf16_t* xb; const float* gfin; float* slots; unsigned* cnt;
    __device__ __forceinline__ void fused(f32x4 (&acc)[2][2][4][2], const Unit& u, int wr, int wc, int fr, int fq, PG8_LAS unsigned char* lds, int wid, int lane) const {
        asm volatile("" : "+v"(fr), "+v"(fq));
        PG8_LAS float* P = (PG8_LAS float*)lds;
        PG8_LAS float* S = (PG8_LAS float*)(lds + 4096);
        const int col0 = u.pn * BM + wc * 32 + 4 * fq, rbase = u.pm * BM + wr * 64 + fr;
        u32x2 xo[2][4][2][2];
#pragma unroll
        for (int ai = 0; ai < 2; ++ai)
#pragma unroll
            for (int m = 0; m < 4; ++m)
#pragma unroll
                for (int bj = 0; bj < 2; ++bj)
#pragma unroll
                    for (int n = 0; n < 2; ++n) xo[ai][m][bj][n] = *(const u32x2*)(xb + (size_t)(rbase + ai * HALF + m * 16) * DM + col0 + bj * HALF + n * 16);
#pragma unroll
        for (int ai = 0; ai < 2; ++ai)
#pragma unroll
            for (int m = 0; m < 4; ++m) { float ss = 0.f;
#pragma unroll
                for (int bj = 0; bj < 2; ++bj)
#pragma unroll
                    for (int n = 0; n < 2; ++n) { const u32x2 wo = xo[ai][m][bj][n];
                        const f32x4 xn = (f32x4){__builtin_bit_cast(float, wo.x << 16), __builtin_bit_cast(float, wo.x & 0xffff0000u), __builtin_bit_cast(float, wo.y << 16), __builtin_bit_cast(float, wo.y & 0xffff0000u)} + acc[ai][bj][m][n];
                        acc[ai][bj][m][n] = xn; ss += (xn[0] * xn[0] + xn[1] * xn[1]) + (xn[2] * xn[2] + xn[3] * xn[3]); }
                ss += __shfl_xor(ss, 16); ss += __shfl_xor(ss, 32);
                if (fq == 0) P[(ai * HALF + wr * 64 + m * 16 + fr) * 4 + wc] = ss; }
        asm volatile("s_waitcnt lgkmcnt(0)" ::: "memory"); __builtin_amdgcn_s_barrier(); asm volatile("" ::: "memory");
        const int tid = wid * 64 + lane;
        if (tid < 256) {
            const float s = (P[tid * 4 + 0] + P[tid * 4 + 1]) + (P[tid * 4 + 2] + P[tid * 4 + 3]);
            __hip_atomic_store((unsigned*)slots + (size_t)(u.pm * BM + tid) * 4 + u.pn, __builtin_bit_cast(unsigned, s), __ATOMIC_RELAXED, __HIP_MEMORY_SCOPE_AGENT);
            asm volatile("s_waitcnt vmcnt(0)" ::: "memory");
            if (lane == 0) __hip_atomic_fetch_add(cnt + 64 * u.pm, 1u, __ATOMIC_RELAXED, __HIP_MEMORY_SCOPE_AGENT);
        }
        if (wid == 0) {
            unsigned spins = 0;
            while ((unsigned)__builtin_amdgcn_readfirstlane(__hip_atomic_load(cnt + 64 * u.pm, __ATOMIC_RELAXED, __HIP_MEMORY_SCOPE_AGENT)) < 16u && ++spins < (1u << 22)) __builtin_amdgcn_s_sleep(2);
            __builtin_amdgcn_fence(__ATOMIC_ACQUIRE, "agent");
        }
        asm volatile("s_waitcnt vmcnt(0) lgkmcnt(0)" ::: "memory"); __builtin_amdgcn_s_barrier(); asm volatile("" ::: "memory");
        f32x4 gv[2][2];
#pragma unroll
        for (int bj = 0; bj < 2; ++bj)
#pragma unroll
            for (int n = 0; n < 2; ++n) gv[bj][n] = *(const f32x4*)(gfin + col0 + bj * HALF + n * 16);
        if (tid < 256) { const unsigned* sl = (const unsigned*)slots + (size_t)(u.pm * BM + tid) * 4; float t = 0.f;
#pragma unroll
            for (int k = 0; k < 4; ++k) t += __builtin_bit_cast(float, __hip_atomic_load(sl + k, __ATOMIC_RELAXED, __HIP_MEMORY_SCOPE_AGENT));
            S[tid] = 1.0f / sqrtf(t * (1.0f / 1024.0f) + EPS); }
        asm volatile("s_waitcnt vmcnt(0) lgkmcnt(0)" ::: "memory"); __builtin_amdgcn_s_barrier(); asm volatile("" ::: "memory");
#pragma unroll
        for (int ai = 0; ai < 2; ++ai)
#pragma unroll
            for (int m = 0; m < 4; ++m) { const float rs = S[ai * HALF + wr * 64 + m * 16 + fr]; float* yr = y + (size_t)(rbase + ai * HALF + m * 16) * DM + col0;
#pragma unroll
                for (int bj = 0; bj < 2; ++bj)
#pragma unroll
                    for (int n = 0; n < 2; ++n) __builtin_nontemporal_store(acc[ai][bj][m][n] * rs * gv[bj][n], (f32x4*)(yr + bj * HALF + n * 16)); }
    }
};
struct EpiMem {
    static constexpr bool PERM = false, AFTER_DRAIN = false;
    float* omk0; float* omv0; bf16_t* mkb0; bf16_t* mvb0; const float* rowsq;
    __device__ __forceinline__ void operator()(const f32x4 (&acc)[2][2][4][2], const Unit& u, int wr, int wc, int fr, int fq) const {
        asm volatile("" : "+v"(fr), "+v"(fq));
        const int lay = u.pn >> 2; const size_t lo_ = (size_t)lay * 512 * 512;
        float* omk = omk0 + lo_; float* omv = omv0 + lo_; bf16_t* mkb = mkb0 + lo_; bf16_t* mvb = mvb0 + lo_;
        const int col0 = (u.pn & 3) * BM + wc * 32 + 4 * fq;
        float rsv[2][4];
#pragma unroll
        for (int ai = 0; ai < 2; ++ai)
#pragma unroll
            for (int m = 0; m < 4; ++m) rsv[ai][m] = rowsq[u.pm * BM + ai * HALF + wr * 64 + m * 16 + fr];
#pragma unroll
        for (int ai = 0; ai < 2; ++ai)
#pragma unroll
            for (int m = 0; m < 4; ++m) {
                const int r = u.pm * BM + ai * HALF + wr * 64 + m * 16 + fr;
                const float rs = __builtin_amdgcn_rsqf(rsv[ai][m] * (1.0f / 1024.0f) + EPS);
#pragma unroll
                for (int bj = 0; bj < 2; ++bj)
#pragma unroll
                    for (int n = 0; n < 2; ++n) { const int c = col0 + bj * HALF + n * 16; const f32x4 v = acc[ai][bj][m][n] * rs;
                        u32x2 w; w.x = cvt_pk_bf16(v[0], v[1]); w.y = cvt_pk_bf16(v[2], v[3]);
                        if (c < DMEMW) { __builtin_nontemporal_store(v, (f32x4*)(omk + (size_t)r * DMEMW + c)); *(u32x2*)(mkb + (size_t)r * DMEMW + c) = w; }
                        else { __builtin_nontemporal_store(v, (f32x4*)(omv + (size_t)r * DMEMW + c - DMEMW)); *(u32x2*)(mvb + (size_t)r * DMEMW + c - DMEMW) = w; } }
            }
    }
};
template <class Epi, class Sched, bool ALIGN_EPI = false, bool SP2 = false>
__device__ __forceinline__ void gemm_phase(PG8_LAS unsigned char* lds, const Gemm g, const Sched& S, const Epi& E) {
    int tid_ = threadIdx.x; asm volatile("" : "+v"(tid_));
    const int tid = tid_, wid = __builtin_amdgcn_readfirstlane(tid >> 6), lane = tid & 63, wr = wid >> 2, wc = wid & 3, fr = lane & 15, fq = lane >> 4;
    const int K = g.K, nt = K / BK;
    unsigned voffA[2], voffB[2];
#pragma unroll
    for (int i = 0; i < 2; ++i) { int R, C; stage_rc(tid * 16 + i * 8192, R, C); const int Rb = Epi::PERM ? ((R & ~31) + perm32(R & 31)) : R;
        voffA[i] = (unsigned)(R * K + C) * 2u; voffB[i] = (unsigned)(Rb * K + C) * 2u; }
    const size_t kstep = (size_t)(BK * 2);
    const size_t hstep = (size_t)HALF * K * 2;
    const size_t tstep = 2 * hstep;
    const unsigned ldsw = (unsigned)wid * 1024u;
    const int aoff = lds_byte(wr * 64 + fr, fq * 8), boff = lds_byte(wc * 32 + fr, fq * 8);
#define PG8_SA(b, h) (((b) * 2 + (h)) * HTB)
#define PG8_SB(b, h) ((4 + (b) * 2 + (h)) * HTB)
#define PG8_STAGE(bufoff, gbase, voff) do { _Pragma("unroll") for (int _i = 0; _i < 2; ++_i) \
        __builtin_amdgcn_global_load_lds((const unsigned*)((const char*)(gbase) + (voff)[_i]), (PG8_LAS unsigned*)(lds + (bufoff) + ldsw + _i * 8192), 16, 0, 0); } while (0)
#define PG8_LDA(dst, b, h) do { _Pragma("unroll") for (int m = 0; m < 4; ++m) _Pragma("unroll") for (int k = 0; k < 2; ++k) dst[m][k] = *(const PG8_LAS bf16x8*)(lds + PG8_SA(b, h) + aoff + m * 2048 + k * 1024); } while (0)
#define PG8_LDB(dst, b, h) do { _Pragma("unroll") for (int n = 0; n < 2; ++n) _Pragma("unroll") for (int k = 0; k < 2; ++k) dst[n][k] = *(const PG8_LAS bf16x8*)(lds + PG8_SB(b, h) + boff + n * 2048 + k * 1024); } while (0)
#define PG8_MMA(ai, bj, At, Bt) do { __builtin_amdgcn_s_setprio(1); _Pragma("unroll") for (int m = 0; m < 4; ++m) _Pragma("unroll") for (int n = 0; n < 2; ++n) _Pragma("unroll") for (int k = 0; k < 2; ++k) \
        acc[ai][bj][m][n] = __builtin_amdgcn_mfma_f32_16x16x32_bf16(Bt[n][k], At[m][k], acc[ai][bj][m][n], 0, 0, 0); __builtin_amdgcn_s_setprio(0); } while (0)
#define PG8_WAIT_V(n) asm volatile("s_waitcnt vmcnt(" #n ")" ::: "memory")
#define PG8_WAIT_L(n) asm volatile("s_waitcnt lgkmcnt(" #n ")" ::: "memory")
#define PG8_BAR __builtin_amdgcn_s_barrier()
#define PG8_SCHED __builtin_amdgcn_sched_barrier(0)
    Unit cur, nxt; int ui = 0;
    if (!S.next(0, cur)) return;
    f32x4 acc[2][2][4][2];
#pragma unroll
    for (int a = 0; a < 2; ++a)
#pragma unroll
        for (int b = 0; b < 2; ++b)
#pragma unroll
            for (int m = 0; m < 4; ++m)
#pragma unroll
                for (int n = 0; n < 2; ++n) acc[a][b][m][n] = (f32x4){0.f, 0.f, 0.f, 0.f};
    bf16x8 At[4][2], B0[2][2], B1[2][2];
    const char* cA = (const char*)g.A + (size_t)cur.pm * tstep; const char* cB = (const char*)g.Bt + (size_t)cur.pn * tstep;
    S.a_ready(cur);
    if constexpr (SP2) {
        PG8_STAGE(PG8_SB(0, 0), cB, voffB); PG8_STAGE(PG8_SB(0, 1), cB + hstep, voffB); PG8_STAGE(PG8_SA(0, 0), cA, voffA); PG8_STAGE(PG8_SA(0, 1), cA + hstep, voffA);
        if (wr == 1) PG8_BAR;
        PG8_WAIT_V(2); PG8_BAR;
        PG8_STAGE(PG8_SB(1, 0), cB + kstep, voffB); PG8_STAGE(PG8_SA(1, 0), cA + kstep, voffA); PG8_STAGE(PG8_SB(1, 1), cB + hstep + kstep, voffB);
        PG8_WAIT_V(6); PG8_BAR;
    } else {
        PG8_STAGE(PG8_SB(0, 0), cB, voffB); PG8_STAGE(PG8_SA(0, 0), cA, voffA); PG8_STAGE(PG8_SB(0, 1), cB + hstep, voffB); PG8_STAGE(PG8_SA(0, 1), cA + hstep, voffA);
        if (wr == 1) PG8_BAR;
        PG8_WAIT_V(4); PG8_BAR;
        PG8_STAGE(PG8_SB(1, 0), cB + kstep, voffB); PG8_STAGE(PG8_SA(1, 0), cA + kstep, voffA); PG8_STAGE(PG8_SB(1, 1), cB + hstep + kstep, voffB);
        PG8_WAIT_V(6); PG8_BAR;
    }
    for (;;) {
        const bool has_next = S.next(ui + 1, nxt);
        const char* nA = has_next ? (const char*)g.A + (size_t)nxt.pm * tstep : cA; const char* nB = has_next ? (const char*)g.Bt + (size_t)nxt.pn * tstep : cB;
        for (int t = 0; t < nt; t += 2) {
            const bool last = (t == nt - 2);
            const char* a1 = cA + (size_t)(t + 1) * kstep;
            const char* a2 = last ? nA : cA + (size_t)(t + 2) * kstep; const char* b2 = last ? nB : cB + (size_t)(t + 2) * kstep;
            const char* a3 = a2 + kstep; const char* b3 = b2 + kstep;
            if (last && has_next) S.a_ready(nxt);
            if constexpr (SP2) {
            PG8_LDB(B0, 0, 0); PG8_LDB(B1, 0, 1); PG8_SCHED; PG8_LDA(At, 0, 0); PG8_STAGE(PG8_SA(1, 1), a1 + hstep, voffA);
            PG8_WAIT_V(8); PG8_WAIT_L(0); PG8_BAR; PG8_MMA(0, 0, At, B0); PG8_MMA(0, 1, At, B1); PG8_BAR; PG8_SCHED;
            PG8_LDA(At, 0, 1); PG8_STAGE(PG8_SB(0, 0), b2, voffB); PG8_STAGE(PG8_SB(0, 1), b2 + hstep, voffB); PG8_STAGE(PG8_SA(0, 0), a2, voffA);
            PG8_WAIT_V(8); PG8_WAIT_L(0); PG8_BAR; PG8_MMA(1, 0, At, B0); PG8_MMA(1, 1, At, B1); PG8_BAR; PG8_SCHED;
            PG8_LDB(B0, 1, 0); PG8_LDB(B1, 1, 1); PG8_SCHED; PG8_LDA(At, 1, 0); PG8_STAGE(PG8_SA(0, 1), a2 + hstep, voffA);
            PG8_WAIT_V(8); PG8_WAIT_L(0); PG8_BAR; PG8_MMA(0, 0, At, B0); PG8_MMA(0, 1, At, B1); PG8_BAR; PG8_SCHED;
            PG8_LDA(At, 1, 1); PG8_STAGE(PG8_SB(1, 0), b3, voffB); PG8_STAGE(PG8_SB(1, 1), b3 + hstep, voffB); PG8_STAGE(PG8_SA(1, 0), a3, voffA);
            PG8_WAIT_V(8); PG8_WAIT_L(0); PG8_BAR; PG8_MMA(1, 0, At, B0); PG8_MMA(1, 1, At, B1); PG8_BAR; PG8_SCHED;
            } else {
            PG8_LDB(B0, 0, 0); PG8_SCHED; PG8_LDA(At, 0, 0); PG8_STAGE(PG8_SA(1, 1), a1 + hstep, voffA);
            PG8_WAIT_L(8); PG8_BAR; PG8_WAIT_L(0); PG8_MMA(0, 0, At, B0); PG8_BAR; PG8_SCHED;
            PG8_LDB(B1, 0, 1); PG8_STAGE(PG8_SB(0, 0), b2, voffB);
            PG8_BAR; PG8_WAIT_L(0); PG8_MMA(0, 1, At, B1); PG8_BAR;
            PG8_LDA(At, 0, 1); PG8_STAGE(PG8_SA(0, 0), a2, voffA);
            PG8_BAR; PG8_WAIT_L(0); PG8_MMA(1, 0, At, B0); PG8_BAR; PG8_SCHED;
            PG8_STAGE(PG8_SB(0, 1), b2 + hstep, voffB);
            PG8_WAIT_V(6); PG8_BAR; PG8_MMA(1, 1, At, B1); PG8_BAR;
            PG8_LDB(B0, 1, 0); PG8_SCHED; PG8_LDA(At, 1, 0); PG8_STAGE(PG8_SA(0, 1), a2 + hstep, voffA);
            PG8_WAIT_L(8); PG8_BAR; PG8_WAIT_L(0); PG8_MMA(0, 0, At, B0); PG8_BAR; PG8_SCHED;
            PG8_LDB(B1, 1, 1); PG8_STAGE(PG8_SB(1, 0), b3, voffB);
            PG8_BAR; PG8_WAIT_L(0); PG8_MMA(0, 1, At, B1); PG8_BAR;
            PG8_LDA(At, 1, 1); PG8_STAGE(PG8_SA(1, 0), a3, voffA);
            PG8_BAR; PG8_WAIT_L(0); PG8_MMA(1, 0, At, B0); PG8_BAR; PG8_SCHED;
            PG8_STAGE(PG8_SB(1, 1), b3 + hstep, voffB);
            PG8_WAIT_V(6); PG8_BAR; PG8_MMA(1, 1, At, B1); PG8_BAR;
            }
        }
        if constexpr (ALIGN_EPI) { if (wr == 0) PG8_BAR; }
        if constexpr (!Epi::AFTER_DRAIN) { E(acc, cur, wr, wc, fr, fq); S.done(cur); }
        if (!has_next) break;
#pragma unroll
        for (int a = 0; a < 2; ++a)
#pragma unroll
            for (int b = 0; b < 2; ++b)
#pragma unroll
                for (int m = 0; m < 4; ++m)
#pragma unroll
                    for (int n = 0; n < 2; ++n) acc[a][b][m][n] = (f32x4){0.f, 0.f, 0.f, 0.f};
        cur = nxt; cA = nA; cB = nB; ++ui;
        if constexpr (ALIGN_EPI) { if (wr == 1) PG8_BAR; }
    }
    PG8_WAIT_V(0);
    if constexpr (!ALIGN_EPI) { if (wr == 0) PG8_BAR; }
    PG8_BAR;
    if constexpr (Epi::AFTER_DRAIN) { E.fused(acc, cur, wr, wc, fr, fq, lds, wid, lane); S.done(cur); }
#undef PG8_SA
#undef PG8_SB
#undef PG8_STAGE
#undef PG8_LDA
#undef PG8_LDB
#undef PG8_MMA
#undef PG8_WAIT_V
#undef PG8_WAIT_L
#undef PG8_BAR
#undef PG8_SCHED
}
}
constexpr size_t MiB = 1u << 20;
constexpr size_t WS_CTL = 0, CTL_ZERO_BYTES = 2 * MiB;
constexpr size_t WS_ROWSQ = 1 * MiB;
constexpr size_t WS_WIN = 2 * MiB, WIN_STRIDE = 7 * MiB;
constexpr size_t WS_WOUT = 30 * MiB, WOUT_STRIDE = 3 * MiB;
constexpr size_t WS_WMEM = 42 * MiB, WMEM_STRIDE = 2 * MiB;
constexpr size_t WS_WG = 50 * MiB;
constexpr size_t WS_ROPE = 51 * MiB;
constexpr size_t WS_XB = 54 * MiB;
constexpr size_t WS_MEMB = 87 * MiB, WS_RSQM = 88 * MiB;
constexpr size_t WS_PROJ = 90 * MiB;
constexpr size_t WS_KB = 188 * MiB, WS_VB = 193 * MiB;
constexpr size_t WS_Z = 198 * MiB;
constexpr size_t WS_MKB = 247 * MiB, WS_MVB = 249 * MiB;
constexpr size_t WS_AGG = 251 * MiB;
constexpr size_t WS_XCHG = 253 * MiB;
constexpr size_t WS_LAB = 256 * MiB, WS_END = 384 * MiB;
constexpr int CW_BAR = 4096;
constexpr int CW_FIN = 458752;
constexpr int CW_LRUF = 393216;

constexpr int RING_OFF = 0, RING_BYTES = 131072;
constexpr int LDS_BYTES = 163840;
constexpr int LDSCTL_OFF = LDS_BYTES - 1024, MISC_OFF = LDSCTL_OFF + 320;
constexpr int NWAVES = 8;

#define GAS __attribute__((address_space(1)))
#define LAS __attribute__((address_space(3)))
typedef unsigned short bf16;
typedef unsigned v4u __attribute__((ext_vector_type(4)));
typedef float f32x4 __attribute__((ext_vector_type(4)));
typedef GAS unsigned gu32;
#define RLX_AGENT __ATOMIC_RELAXED, __HIP_MEMORY_SCOPE_AGENT
#define LDS_WAIT() asm volatile("s_waitcnt lgkmcnt(0)" ::: "memory")
#define VM_WAIT() asm volatile("s_waitcnt vmcnt(0)" ::: "memory")
__device__ __forceinline__ unsigned f2bf(float f) { unsigned u = __builtin_bit_cast(unsigned, f); return (u + 0x7fffu + ((u >> 16) & 1u)) >> 16; }
__device__ __forceinline__ unsigned pk2(float lo, float hi) { return f2bf(lo) | (f2bf(hi) << 16); }
__device__ __forceinline__ float bf2f(bf16 h) { return __builtin_bit_cast(float, (unsigned)h << 16); }
__device__ __forceinline__ float wave_sum(float v) {
#pragma unroll
    for (int o = 1; o < 64; o <<= 1) v += __shfl_xor(v, o);
    return v;
}
__device__ __forceinline__ float wave_max(float v) {
#pragma unroll
    for (int o = 1; o < 64; o <<= 1) v = fmaxf(v, __shfl_xor(v, o));
    return v;
}
__device__ const float INVF[32] = {1.000000000e+00f, 7.498942614e-01f, 5.623413324e-01f, 4.216965139e-01f, 3.162277639e-01f, 2.371373773e-01f, 1.778279394e-01f, 1.333521307e-01f,
    1.000000015e-01f, 7.498941571e-02f, 5.623413250e-02f, 4.216965288e-02f, 3.162277490e-02f, 2.371373773e-02f, 1.778279431e-02f, 1.333521493e-02f,
    9.999999776e-03f, 7.498941850e-03f, 5.623413250e-03f, 4.216964822e-03f, 3.162277630e-03f, 2.371373586e-03f, 1.778279431e-03f, 1.333521446e-03f,
    1.000000047e-03f, 7.498942432e-04f, 5.623413017e-04f, 4.216965172e-04f, 3.162277571e-04f, 2.371373703e-04f, 1.778279402e-04f, 1.333521504e-04f};
#define XB_TMO      128
#define XB_XCNT(j)  (256  + 64 * (j))
#define XB_XSUB(j)  (1280 + 64 * (j))
#define XB_XGEN(j)  (2304 + 64 * (j))
#define XB_TOP      3328
#define XB_TOPGEN   3392
#define XCD_BAR_WORDS 3456
#define XB_SPIN_CAP (1u << 18)

__device__ __forceinline__ unsigned xb_ld(unsigned* p)              { return __hip_atomic_load(p, __ATOMIC_RELAXED, __HIP_MEMORY_SCOPE_AGENT); }
__device__ __forceinline__ unsigned xb_add(unsigned* p, unsigned v) { return __hip_atomic_fetch_add(p, v, __ATOMIC_RELAXED, __HIP_MEMORY_SCOPE_AGENT); }
__device__ __forceinline__ unsigned xb_xcc_id() { return (unsigned)__builtin_amdgcn_s_getreg((3 << 11) | 20) & 0xFu; }
#define XB_SPIN(cond, bar) do { unsigned _sp = 0; while (cond) { __builtin_amdgcn_s_sleep(1); \
    if ((++_sp & 255u) == 0u) { if (xb_ld(&(bar)[XB_TMO])) break; if (_sp > XB_SPIN_CAP) { atomicAdd(&(bar)[XB_TMO], 1u); break; } } } } while (0)

struct XcdBarrier {
    unsigned* bar; unsigned x;
    volatile LAS unsigned* st;
};

__device__ __forceinline__ XcdBarrier xcd_barrier_post(unsigned* bar, volatile LAS unsigned* st) {
    XcdBarrier b; b.bar = bar; b.x = xb_xcc_id(); b.st = st;
    if (threadIdx.x == 0) (void)xb_add(&bar[XB_XCNT(b.x)], 1u);
    return b;
}
__device__ __forceinline__ void xcd_barrier_complete(unsigned* bar, unsigned x, unsigned& nloc, unsigned& nx) {
    const unsigned G = gridDim.x * gridDim.y * gridDim.z;
    unsigned sum, cnt, mine, sp = 0u;
    for (;;) {
        sum = 0u; cnt = 0u; mine = 0u;
#pragma unroll
        for (unsigned j = 0; j < 16; ++j) { const unsigned c = xb_ld(&bar[XB_XCNT(j)]); sum += c; cnt += (c > 0u) ? 1u : 0u; mine = (j == x) ? c : mine; }
        if (sum == G) break;
        __builtin_amdgcn_s_sleep(1);
        if ((++sp & 255u) == 0u) { if (xb_ld(&bar[XB_TMO])) break; if (sp > XB_SPIN_CAP) { atomicAdd(&bar[XB_TMO], 1u); break; } }
    }
    nloc = mine > 0u ? mine : 1u; nx = cnt > 0u ? cnt : 1u;
}

__device__ __forceinline__ void xcd_barrier(const XcdBarrier& b) {
    asm volatile("s_waitcnt vmcnt(0)" ::: "memory");
    __syncthreads();
    if (threadIdx.x == 0) {
        unsigned* bar = b.bar;
        __builtin_amdgcn_s_waitcnt(0);
        unsigned nloc = b.st[0], nx = b.st[1];
        if (nloc == 0u) { xcd_barrier_complete(bar, b.x, nloc, nx); b.st[0] = nloc; b.st[1] = nx; }
        const unsigned old = xb_add(&bar[XB_XSUB(b.x)], 1u);
        const unsigned gen = old / nloc;
        if (old + 1u == (gen + 1u) * nloc) {
            __builtin_amdgcn_fence(__ATOMIC_RELEASE, "agent");
            asm volatile("s_waitcnt vmcnt(0)" ::: "memory");
            const unsigned og = xb_add(&bar[XB_TOP], 1u);
            const unsigned tg = og / nx;
            if (og + 1u == (tg + 1u) * nx) xb_add(&bar[XB_TOPGEN], 1u);
            else XB_SPIN(xb_ld(&bar[XB_TOPGEN]) == tg, bar);
            __builtin_amdgcn_fence(__ATOMIC_ACQUIRE, "agent");
            xb_add(&bar[XB_XGEN(b.x)], 1u);
            asm volatile("s_waitcnt vmcnt(0)" ::: "memory");
        } else {
            XB_SPIN(xb_ld(&bar[XB_XGEN(b.x)]) == gen, bar);
            __builtin_amdgcn_fence(__ATOMIC_ACQUIRE, "agent");
            asm volatile("s_waitcnt vmcnt(0)" ::: "memory");
        }
    }
    __syncthreads();
}
enum { I_XP = 0, I_XS, I_CMK, I_CMV, I_STH, I_STC, I_CWK, I_CWV, I_MEMP, I_NORMG, I_WIN, I_WOUT, I_MEMNG, I_WMEMKV, I_CONVW, I_CONVB, I_WA, I_BA, I_WX, I_BX, I_LAM, I_KVNG, I_WKV, I_SINKS, I_FINALG, N_IN };
struct Args { const float* in[N_IN]; float* out; unsigned char* ws; int ph_lo, ph_hi; };

typedef const __attribute__((address_space(4))) Args* ArgsP;
__device__ __forceinline__ ArgsP get_args() { ArgsP p = (ArgsP)__builtin_amdgcn_kernarg_segment_ptr(); asm volatile("" : "+s"(p)); return p; }
struct Ids { int tid, lane, wave, gw, NGW, gtid, GT; };
__device__ __forceinline__ Ids make_ids() {
    Ids I; int tid = threadIdx.x; asm volatile("" : "+v"(tid));
    I.tid = tid; I.lane = tid & 63; I.wave = __builtin_amdgcn_readfirstlane(tid >> 6);
    int G = gridDim.x, bx = blockIdx.x; asm volatile("" : "+s"(G), "+s"(bx));
    const int vcu = (G % 8 == 0) ? (bx % 8) * (G / 8) + bx / 8 : bx;
    I.gw = vcu * 8 + I.wave; I.NGW = G * 8; I.gtid = vcu * 512 + tid; I.GT = G * 512; return I;
}

__device__ __forceinline__ int permpos(int d) { return d < 32 ? 8 * (d >> 2) + (d & 3) : 8 * ((d - 32) >> 2) + 4 + (d & 3); }
__device__ __forceinline__ int permdim(int p) { return 32 * ((p >> 2) & 1) + 4 * (p >> 3) + (p & 3); }
__device__ __forceinline__ void p0_transpose_item(const float* W, int K, int N, const float* gs, bf16* WT, int row_off, int perm_cols, LAS float* scr, int item, int lane) {
    const int nblk = N / 32, kb = item / nblk, nb = item % nblk, k0 = 64 * kb, n0 = 32 * nb;
    f32x4 wv[8]; float gv[8];
#pragma unroll
    for (int i = 0; i < 8; ++i) { const int kk = (lane >> 3) + 8 * i; wv[i] = *(const f32x4*)(W + (size_t)(k0 + kk) * N + n0 + 4 * (lane & 7)); gv[i] = gs ? gs[k0 + kk] : 1.0f; }
    __builtin_amdgcn_sched_barrier(0);
#pragma unroll
    for (int i = 0; i < 8; ++i) { const int kk = (lane >> 3) + 8 * i; LAS float* d = scr + kk * 33 + 4 * (lane & 7);
        d[0] = wv[i][0] * gv[i]; d[1] = wv[i][1] * gv[i]; d[2] = wv[i][2] * gv[i]; d[3] = wv[i][3] * gv[i]; }
    LDS_WAIT(); asm volatile("" ::: "memory");
    const int c = lane & 7;
#pragma unroll
    for (int j = 0; j < 4; ++j) { const int n = (lane >> 3) + 8 * j; const LAS float* s = scr + (8 * c) * 33 + n;
        v4u o; o.x = pk2(s[0 * 33], s[1 * 33]); o.y = pk2(s[2 * 33], s[3 * 33]); o.z = pk2(s[4 * 33], s[5 * 33]); o.w = pk2(s[6 * 33], s[7 * 33]);
        const int nn = n0 + n; const int row = nn < perm_cols ? (nn & ~63) + permpos(nn & 63) : nn;
        *(GAS v4u*)(WT + (size_t)(row_off + row) * K + k0 + 8 * c) = o; }
    LDS_WAIT(); asm volatile("" ::: "memory");
}
__device__ __forceinline__ void row_to_bf16(const float* xrow, bf16* orow, float* sq, int lane) {
    const GAS f32x4* xr = (const GAS f32x4*)xrow + lane;
    f32x4 v[4]; float s = 0.f;
#pragma unroll
    for (int j = 0; j < 4; ++j) { v[j] = xr[64 * j]; s += (v[j].x * v[j].x + v[j].y * v[j].y) + (v[j].z * v[j].z + v[j].w * v[j].w); }
    s = wave_sum(s);
    GAS unsigned long long* o8 = (GAS unsigned long long*)orow + lane;
#pragma unroll
    for (int j = 0; j < 4; ++j) o8[64 * j] = (unsigned long long)pk2(v[j].x, v[j].y) | ((unsigned long long)pk2(v[j].z, v[j].w) << 32);
    if (lane == 0) *sq = s;
}
__device__ __forceinline__ void sincos_f32arg(float angf, float& c, float& s) {
    const double x = (double)angf;
    const double kq = __builtin_rint(x * 0.63661977236758134308);
    double r = __builtin_fma(-kq, 1.57079632679489655800e+00, x); r = __builtin_fma(-kq, 6.12323399573676603587e-17, r);
    const double r2 = r * r;
    double sp = 1.0 / 6227020800.0; sp = sp * r2 - 1.0 / 39916800.0; sp = sp * r2 + 1.0 / 362880.0; sp = sp * r2 - 1.0 / 5040.0; sp = sp * r2 + 1.0 / 120.0; sp = sp * r2 - 1.0 / 6.0; sp = sp * r2 + 1.0; sp = sp * r;
    double cp = -1.0 / 87178291200.0; cp = cp * r2 + 1.0 / 479001600.0; cp = cp * r2 - 1.0 / 3628800.0; cp = cp * r2 + 1.0 / 40320.0; cp = cp * r2 - 1.0 / 720.0; cp = cp * r2 + 1.0 / 24.0; cp = cp * r2 - 0.5; cp = cp * r2 + 1.0;
    const int q = ((int)kq) & 3;
    const double cc = (q == 0) ? cp : (q == 1) ? -sp : (q == 2) ? -cp : sp;
    const double ss = (q == 0) ? sp : (q == 1) ? cp : (q == 2) ? -sp : -cp;
    c = (float)cc; s = (float)ss;
}
struct WJob { const float* W; const float* gs; bf16* WT; int K, N, row_off, perm_cols; };
__device__ __forceinline__ void wtile_fetch(float (&v)[32], const WJob& J, int tile, int tid) {
    const int ntn = J.N >> 8, kb = tile / ntn, nb = tile - kb * ntn;
#pragma unroll
    for (int i = 0; i < 32; ++i) { const int idx = tid + 512 * i, row = idx >> 8, col = idx & 255; v[i] = __builtin_nontemporal_load(&J.W[(size_t)(64 * kb + row) * J.N + 256 * nb + col]); }
}
__device__ __forceinline__ void wtile_put(const float (&v)[32], const WJob& J, int tile, int tid, LAS float* scr) {
    const int ntn = J.N >> 8, kb = tile / ntn;
#pragma unroll
    for (int i = 0; i < 32; ++i) { const int idx = tid + 512 * i, row = idx >> 8, col = idx & 255; scr[row * 257 + col] = v[i] * (J.gs ? J.gs[64 * kb + row] : 1.0f); }
}
__device__ __forceinline__ void wtile_store(const WJob& J, int tile, int tid, const LAS float* scr) {
    const int ntn = J.N >> 8, kb = tile / ntn, nb = tile - kb * ntn, c = tid & 7;
#pragma unroll
    for (int j = 0; j < 4; ++j) { const int n = (tid >> 3) + 64 * j; const LAS float* sp = scr + (8 * c) * 257 + n;
        v4u o; o.x = pk2(sp[0 * 257], sp[1 * 257]); o.y = pk2(sp[2 * 257], sp[3 * 257]); o.z = pk2(sp[4 * 257], sp[5 * 257]); o.w = pk2(sp[6 * 257], sp[7 * 257]);
        const int nn = 256 * nb + n; const int row = nn < J.perm_cols ? (nn & ~63) + permpos(nn & 63) : nn;
        *(GAS v4u*)(J.WT + (size_t)(J.row_off + row) * J.K + 64 * kb + 8 * c) = o; }
}
__device__ __forceinline__ WJob wjob(ArgsP A, int kind, int l) {
    unsigned char* ws = A->ws; WJob J;
    if (kind == 0) { J.W = A->in[I_WIN] + (size_t)l * DM * DIN; J.gs = A->in[I_NORMG] + l * DM; J.WT = (bf16*)(ws + WS_WIN + l * WIN_STRIDE); J.K = DM; J.N = DIN; J.row_off = 0; J.perm_cols = l >= N_A ? DMAIN : 0; }
    else if (kind == 1) { J.W = A->in[I_WKV]; J.gs = A->in[I_KVNG]; J.WT = (bf16*)(ws + WS_WIN + N_A * WIN_STRIDE); J.K = DM; J.N = 256; J.row_off = DIN; J.perm_cols = 128; }
    else if (kind == 2) { J.W = A->in[I_WOUT] + (size_t)l * DCAT * DM; J.gs = nullptr; J.WT = (bf16*)(ws + WS_WOUT + l * WOUT_STRIDE); J.K = DCAT; J.N = DM; J.row_off = 0; J.perm_cols = 0; }
    else { J.W = A->in[I_WMEMKV] + (size_t)l * DM * DM; J.gs = A->in[I_MEMNG] + l * DM; J.WT = (bf16*)(ws + WS_WMEM + l * WMEM_STRIDE); J.K = DM; J.N = DM; J.row_off = 0; J.perm_cols = 0; }
    return J;
}
constexpr int WT_IN = (DM / 64) * (DIN / 256), WT_KV = DM / 64, WT_OUT = (DCAT / 64) * (DM / 256), WT_MEM = (DM / 64) * (DM / 256);
template <bool LATE> __device__ __forceinline__ void wlist_decode(ArgsP A, int it, WJob& J, int& tile) {
    if (!LATE) { const int l = it / WT_MEM; J = wjob(A, 3, l); tile = it - l * WT_MEM; return; }
    if (it < WT_IN) { J = wjob(A, 0, 0); tile = it; return; } it -= WT_IN;
    if (it < WT_OUT) { J = wjob(A, 2, 0); tile = it; return; } it -= WT_OUT;
    if (it < 3 * WT_IN) { const int l = 1 + it / WT_IN; J = wjob(A, 0, l); tile = it - (l - 1) * WT_IN; return; } it -= 3 * WT_IN;
    if (it < WT_KV) { J = wjob(A, 1, 0); tile = it; return; } it -= WT_KV;
    { const int l = 1 + it / WT_OUT; J = wjob(A, 2, l); tile = it - (l - 1) * WT_OUT; }
}
template <bool LATE> __device__ __forceinline__ void wlist_run(ArgsP A, LAS unsigned char* lds, int slot, int nslots) {
    constexpr int NIT = LATE ? (WT_IN + WT_OUT + 3 * WT_IN + WT_KV + 3 * WT_OUT) : (DEPTH * WT_MEM);
    int tid = threadIdx.x; asm volatile("" : "+v"(tid));
    LAS float* scr = (LAS float*)(lds + RING_OFF);
    float v[32]; WJob J; int tile;
    int it = slot;
    if (it < NIT) { wlist_decode<LATE>(A, it, J, tile); wtile_fetch(v, J, tile, tid); }
#pragma unroll 1
    for (; it < NIT; it += nslots) {
        wlist_decode<LATE>(A, it, J, tile);
        wtile_put(v, J, tile, tid, scr);
        __syncthreads();
        const int nx = it + nslots;
        if (nx < NIT) { WJob Jn; int tn; wlist_decode<LATE>(A, nx, Jn, tn); wtile_fetch(v, Jn, tn, tid); }
        __builtin_amdgcn_sched_barrier(0);
        wtile_store(J, tile, tid, scr);
        __syncthreads();
    }
}
__device__ __forceinline__ void p0_rows(ArgsP A, int m_lo, int m_hi, int wslot, int nslots) {
    const Ids I = make_ids();
    unsigned char* ws = A->ws;
    bf16* xb = (bf16*)(ws + WS_XB); float* rowsq0 = (float*)(ws + WS_ROWSQ);
    for (int m0 = m_lo + 2 * wslot; m0 < m_hi; m0 += 2 * nslots) {
        f32x4 v[2][4]; const float* src[2]; bf16* dst[2]; float* sq[2];
#pragma unroll
        for (int t = 0; t < 2; ++t) { const int m = m0 + t;
            if (m < MP) { src[t] = A->in[I_XP] + (size_t)m * DM; dst[t] = xb + (size_t)m * DM; sq[t] = rowsq0 + m; }
            else if (m < MV) { src[t] = A->in[I_XS] + (size_t)(m - MP) * DM; dst[t] = xb + (size_t)m * DM; sq[t] = rowsq0 + m; }
            else if (m < MPAD) { src[t] = nullptr; dst[t] = xb + (size_t)m * DM; sq[t] = rowsq0 + m; }
            else { const int mm = m - MPAD; src[t] = A->in[I_MEMP] + (size_t)mm * DM; dst[t] = (bf16*)(ws + WS_MEMB) + (size_t)mm * DM; sq[t] = (float*)(ws + WS_RSQM) + mm; }
#pragma unroll
            for (int j = 0; j < 4; ++j) v[t][j] = src[t] ? __builtin_nontemporal_load((const GAS f32x4*)src[t] + I.lane + 64 * j) : (f32x4){0.f, 0.f, 0.f, 0.f}; }
        __builtin_amdgcn_sched_barrier(0);
#pragma unroll
        for (int t = 0; t < 2; ++t) { float s2 = 0.f;
#pragma unroll
            for (int j = 0; j < 4; ++j) s2 += (v[t][j].x * v[t][j].x + v[t][j].y * v[t][j].y) + (v[t][j].z * v[t][j].z + v[t][j].w * v[t][j].w);
            s2 = wave_sum(s2);
            GAS unsigned long long* o8 = (GAS unsigned long long*)dst[t] + I.lane;
#pragma unroll
            for (int j = 0; j < 4; ++j) o8[64 * j] = (unsigned long long)pk2(v[t][j].x, v[t][j].y) | ((unsigned long long)pk2(v[t][j].z, v[t][j].w) << 32);
            if (I.lane == 0) *sq[t] = s2; }
    }
}
__device__ __forceinline__ void p0_rope(ArgsP A, int tslot, int ntslots) {
    float* rope = (float*)(A->ws + WS_ROPE);
    for (int e = tslot; e < (SEQ + 1) * 32; e += ntslots) { const int pos = e >> 5, i = e & 31; float c, s; sincos_f32arg((float)pos * INVF[i], c, s); rope[(size_t)pos * 64 + i] = c; rope[(size_t)pos * 64 + 32 + i] = s; }
}
__device__ __forceinline__ void p0_misc(ArgsP A, int tslot, int ntslots) {
    unsigned char* ws = A->ws;
    { bf16* wgt = (bf16*)(ws + WS_WG);
      for (int e = tslot; e < N_A * 2 * 16 * 4096; e += ntslots) { const int cin = e & 63, cout = (e >> 6) & 63, blk = (e >> 12) & 15, gate = (e >> 16) & 1, l = e >> 17;
          const float* src = (gate ? A->in[I_WX] : A->in[I_WA]) + ((size_t)(l * 16 + blk) * 64 + cin) * 64 + cout; wgt[e] = (bf16)f2bf(*src); } }
    for (int e0 = tslot; e0 < MS * 127 * 32; e0 += 4 * ntslots) {
        f32x4 kv[4], vv[4]; size_t off[4];
#pragma unroll
        for (int t = 0; t < 4; ++t) { const int e = e0 + t * ntslots; const bool ok = e < MS * 127 * 32; const int ee = ok ? e : 0; const int sb = ee / (127 * 32), rem = ee - sb * (127 * 32);
            off[t] = ok ? (size_t)sb * WIN * 128 + rem * 4 : (size_t)-1;
            if (ok) { kv[t] = __builtin_nontemporal_load((const f32x4*)(A->in[I_CWK] + off[t] + 128)); vv[t] = __builtin_nontemporal_load((const f32x4*)(A->in[I_CWV] + off[t] + 128)); } }
        __builtin_amdgcn_sched_barrier(0);
#pragma unroll
        for (int t = 0; t < 4; ++t) if (off[t] != (size_t)-1) { __builtin_nontemporal_store(kv[t], (f32x4*)(A->out + O_WKS + off[t])); __builtin_nontemporal_store(vv[t], (f32x4*)(A->out + O_WVS + off[t])); }
    }
}

__device__ __forceinline__ void final_norm_row(ArgsP A, int m, int lane) {
    const float* rsq = (const float*)(A->ws + WS_ROWSQ) + 4 * MPAD; const bf16* xb = (const bf16*)(A->ws + WS_XB);
    unsigned long long xv[4];
#pragma unroll
    for (int j = 0; j < 4; ++j) xv[j] = ((const GAS unsigned long long*)(xb + (size_t)m * DM))[lane + 64 * j];
    const float rs = 1.0f / sqrtf(rsq[m] * (1.0f / 1024.0f) + EPS);
    GAS f32x4* yr = (GAS f32x4*)(A->out + (size_t)m * DM) + lane; const GAS f32x4* gr = (const GAS f32x4*)A->in[I_FINALG] + lane;
#pragma unroll
    for (int j = 0; j < 4; ++j) { const unsigned lo = (unsigned)xv[j], hi = (unsigned)(xv[j] >> 32);
        const f32x4 x = {__builtin_bit_cast(float, lo << 16), __builtin_bit_cast(float, lo & 0xffff0000u), __builtin_bit_cast(float, hi << 16), __builtin_bit_cast(float, hi & 0xffff0000u)};
        yr[64 * j] = x * rs * gr[64 * j]; }
}
typedef short bf16x8 __attribute__((ext_vector_type(8)));
typedef float f32x16 __attribute__((ext_vector_type(16)));
typedef unsigned u32x2v __attribute__((ext_vector_type(2)));
__device__ __forceinline__ int crow(int r, int hi) { return (r & 3) + 8 * (r >> 2) + 4 * hi; }
typedef float f32x2_t __attribute__((ext_vector_type(2))); typedef __bf16 bf16x2_t __attribute__((ext_vector_type(2)));
__device__ __forceinline__ unsigned cvtpk(float lo, float hi) { f32x2_t v = {lo, hi}; bf16x2_t b = __builtin_convertvector(v, bf16x2_t); return __builtin_bit_cast(unsigned, b); }

template <int NKS> __device__ __forceinline__ f32x16 qk_tile(const LAS unsigned char* Kl, int KS, int kt, const bf16x8 (&qf)[NKS], int lane) {
    f32x16 acc = {0.f, 0.f, 0.f, 0.f, 0.f, 0.f, 0.f, 0.f, 0.f, 0.f, 0.f, 0.f, 0.f, 0.f, 0.f, 0.f};
    const LAS unsigned char* kp = Kl + (32 * kt + (lane & 31)) * KS + 16 * (lane >> 5);
#pragma unroll
    for (int ks = 0; ks < NKS; ++ks) { const bf16x8 kf = *(const LAS bf16x8*)(kp + 32 * ks); acc = __builtin_amdgcn_mfma_f32_32x32x16_bf16(kf, qf[ks], acc, 0, 0, 0); }
    __builtin_amdgcn_sched_barrier(0);
    return acc;
}
__device__ __forceinline__ void pack_tile(v4u (&pw)[2], const f32x16& p) {
#pragma unroll
    for (int s = 0; s < 2; ++s) { pw[s].x = cvtpk(p[8 * s + 0], p[8 * s + 1]); pw[s].y = cvtpk(p[8 * s + 2], p[8 * s + 3]); pw[s].z = cvtpk(p[8 * s + 4], p[8 * s + 5]); pw[s].w = cvtpk(p[8 * s + 6], p[8 * s + 7]); }
}
template <int NT> __device__ __forceinline__ f32x16 pv_block(const v4u (&pw)[NT][2], const LAS unsigned char* Vl, int VS, int d0, int kt0, int lane) {
    f32x16 o = {0.f, 0.f, 0.f, 0.f, 0.f, 0.f, 0.f, 0.f, 0.f, 0.f, 0.f, 0.f, 0.f, 0.f, 0.f, 0.f};
    const LAS unsigned char* vbase = Vl + (d0 + (lane & 31)) * VS + 8 * (lane >> 5) + 64 * kt0;
#pragma unroll
    for (int i = 0; i < NT; ++i)
#pragma unroll
        for (int s = 0; s < 2; ++s) {
            const LAS unsigned char* vp = vbase + 64 * i + 32 * s;
            const u32x2v lo = *(const LAS u32x2v*)vp, hi = *(const LAS u32x2v*)(vp + 16);
            v4u vw; vw.x = lo.x; vw.y = lo.y; vw.z = hi.x; vw.w = hi.y;
            o = __builtin_amdgcn_mfma_f32_32x32x16_bf16(__builtin_bit_cast(bf16x8, pw[i][s]), __builtin_bit_cast(bf16x8, vw), o, 0, 0, 0);
            if (s == 1 && (i & 1)) __builtin_amdgcn_sched_barrier(0);
        }
    __builtin_amdgcn_sched_barrier(0);
    return o;
}
__device__ __forceinline__ void store_gated(const f32x16& o, bf16* zrow0, const bf16* grow0, unsigned col, int lane) {
    const unsigned zo = (unsigned)(4 * (lane >> 5)) * DCAT + col, go = (unsigned)(4 * (lane >> 5)) * DIN + col;
#pragma unroll
    for (int g = 0; g < 4; ++g) {
        float gv[4];
#pragma unroll
        for (int i = 0; i < 4; ++i) gv[i] = bf2f(grow0[go + (unsigned)(8 * g + i) * DIN]);
#pragma unroll
        for (int i = 0; i < 4; ++i) zrow0[zo + (unsigned)(8 * g + i) * DCAT] = (bf16)f2bf(o[4 * g + i] * gv[i]);
        __builtin_amdgcn_sched_barrier(0);
    }
}
__device__ __forceinline__ void stage_write(LAS unsigned char* st, int RS, const f32x16& o, int db, int lane) {
    LAS unsigned short* p = (LAS unsigned short*)(st + (4 * (lane >> 5)) * RS + (32 * db + (lane & 31)) * 2);
#pragma unroll
    for (int e = 0; e < 16; e += 2) { const unsigned w = cvtpk(o[e], o[e + 1]);
        p[((e & 3) + 8 * (e >> 2)) * (RS / 2)] = (unsigned short)(w & 0xffffu); p[(((e + 1) & 3) + 8 * ((e + 1) >> 2)) * (RS / 2)] = (unsigned short)(w >> 16); }
}
__device__ __forceinline__ unsigned mul_bf16x2(unsigned a, unsigned b) {
    return cvtpk(__builtin_bit_cast(float, a << 16) * __builtin_bit_cast(float, b << 16), __builtin_bit_cast(float, a & 0xffff0000u) * __builtin_bit_cast(float, b & 0xffff0000u)); }
__device__ __forceinline__ v4u mul_bf16x8(const v4u a, const v4u b) { v4u r; r.x = mul_bf16x2(a.x, b.x); r.y = mul_bf16x2(a.y, b.y); r.z = mul_bf16x2(a.z, b.z); r.w = mul_bf16x2(a.w, b.w); return r; }
template <int CH> __device__ __forceinline__ void gate_load(v4u (&gate)[CH / 2], const bf16* grow0  , int lane) {
    const bf16* gp = grow0 + (size_t)(lane / CH) * DIN + (lane % CH) * 8;
#pragma unroll
    for (int j = 0; j < CH / 2; ++j) gate[j] = *(const v4u*)(gp + (size_t)((64 / CH) * j) * DIN);
}
template <int CH> __device__ __forceinline__ void stage_store(const LAS unsigned char* st, int RS, const v4u (&gate)[CH / 2], bf16* zrow0  , int lane) {
    const LAS unsigned char* sp = st + (lane / CH) * RS + (lane % CH) * 16; bf16* zp = zrow0 + (size_t)(lane / CH) * DCAT + (lane % CH) * 8;
#pragma unroll
    for (int j = 0; j < CH / 2; ++j) { const v4u o = *(const LAS v4u*)(sp + ((64 / CH) * j) * RS); *(v4u*)(zp + (size_t)((64 / CH) * j) * DCAT) = mul_bf16x8(o, gate[j]); }
}

constexpr int SWA_KS = 144, SWA_VS = 520;
constexpr int SWA_K_OFF = 0, SWA_V_OFF = 256 * SWA_KS, SWA_ST_OFF = SWA_V_OFF + 64 * SWA_VS, SWA_ST_RS = 144;
__device__ __forceinline__ void swa_unit(ArgsP A, const Ids& I, int l, int unit, LAS unsigned char* lds) {
    const int b = unit >> 7, n = (unit >> 1) & 63, kvh = unit & 1;
    const bf16* proj = (const bf16*)(A->ws + WS_PROJ); bf16* z = (bf16*)(A->ws + WS_Z);
    const bf16* kb = (const bf16*)(A->ws + WS_KB); const bf16* vb = (const bf16*)(A->ws + WS_VB);
    LAS unsigned char* Kl = lds + SWA_K_OFF; LAS unsigned char* Vl = lds + SWA_V_OFF;
    const long tok0 = (long)b * SEQ + 128 * (n - 1);
    int tid_o = I.tid; asm volatile("" : "+v"(tid_o));
    {
        const int row = (tid_o & 63) + 64 * ((tid_o >> 6) & 3), ch0 = 4 * (tid_o >> 8);
        const bool ok = n > 0 || row >= 128; const int rr = ok ? row : 128;
        const bf16* kp = kb + (size_t)(tok0 + rr) * 128 + kvh * 64 + ch0 * 8; const bf16* vp = vb + (size_t)(tok0 + rr) * 128 + kvh * 64 + ch0 * 8;
        v4u kv[4], vv[4];
#pragma unroll
        for (int j = 0; j < 4; ++j) { kv[j] = *(const v4u*)(kp + 8 * j); vv[j] = *(const v4u*)(vp + 8 * j); }
        __builtin_amdgcn_sched_barrier(0);
#pragma unroll
        for (int j = 0; j < 4; ++j) { const int ch = ch0 + j; const v4u k = ok ? kv[j] : (v4u){0u, 0u, 0u, 0u}, v = ok ? vv[j] : (v4u){0u, 0u, 0u, 0u};
            *(LAS v4u*)(Kl + row * SWA_KS + ch * 16) = k;
            LAS unsigned short* vt = (LAS unsigned short*)(Vl + (ch * 8) * SWA_VS + row * 2);
            vt[0 * (SWA_VS / 2)] = (unsigned short)(v.x & 0xffffu); vt[1 * (SWA_VS / 2)] = (unsigned short)(v.x >> 16);
            vt[2 * (SWA_VS / 2)] = (unsigned short)(v.y & 0xffffu); vt[3 * (SWA_VS / 2)] = (unsigned short)(v.y >> 16);
            vt[4 * (SWA_VS / 2)] = (unsigned short)(v.z & 0xffffu); vt[5 * (SWA_VS / 2)] = (unsigned short)(v.z >> 16);
            vt[6 * (SWA_VS / 2)] = (unsigned short)(v.w & 0xffffu); vt[7 * (SWA_VS / 2)] = (unsigned short)(v.w >> 16); }
    }
    __syncthreads();
    const int h = kvh * 8 + I.wave;
    const float sink2 = A->in[I_SINKS][(l - N_A) * NHEADS + h] * LOG2E;
    const size_t row0 = (size_t)b * SEQ + 128 * n;
    bf16x8 qfb[2][4]; v4u gateb[2][4];
    { int lane0 = tid_o & 63; asm volatile("" : "+v"(lane0));
      const bf16* qp = proj + (row0 + (lane0 & 31)) * DIN + h * 64 + 8 * (lane0 >> 5);
#pragma unroll
      for (int ks = 0; ks < 4; ++ks) qfb[0][ks] = *(const bf16x8*)(qp + 16 * ks);
      gate_load<8>(gateb[0], proj + row0 * DIN + DMAIN + h * 64, lane0); }
#pragma unroll
    for (int r = 0; r < 4; ++r) {
        int lane = tid_o & 63; asm volatile("" : "+v"(lane));
        const int q = lane & 31, hi = lane >> 5;
        if (r < 3) { const bf16* qp = proj + (row0 + 32 * (r + 1) + q) * DIN + h * 64 + 8 * hi;
#pragma unroll
            for (int ks = 0; ks < 4; ++ks) qfb[(r + 1) & 1][ks] = *(const bf16x8*)(qp + 16 * ks);
            gate_load<8>(gateb[(r + 1) & 1], proj + (row0 + 32 * (r + 1)) * DIN + DMAIN + h * 64, lane); }
        __builtin_amdgcn_sched_barrier(0);
        const bf16x8 (&qf)[4] = qfb[r & 1]; const v4u (&gate)[4] = gateb[r & 1];
        f32x16 s[5];
#pragma unroll
        for (int i = 0; i < 5; ++i) s[i] = qk_tile<4>(Kl, SWA_KS, r + i, qf, lane);
        const float NEG = -1.0e30f;
        {
            const int dbase = 4 * hi - q; const unsigned NEGB = __builtin_bit_cast(unsigned, NEG), MAXB = 0x7f7fffffu;
#pragma unroll
            for (int e = 0; e < 16; ++e) { const int d = dbase + (e & 3) + 8 * (e >> 2);
                const unsigned m0 = ((unsigned)((d - 1) >> 31) & (NEGB ^ MAXB)) ^ MAXB, m4 = ((unsigned)((-d) >> 31) & (NEGB ^ MAXB)) ^ MAXB;
                s[0][e] = fminf(s[0][e], __builtin_bit_cast(float, m0)); s[4][e] = fminf(s[4][e], __builtin_bit_cast(float, m4)); }
        }
        if (n == 0) {
#pragma unroll
            for (int i = 0; i < 4; ++i) if (r + i < 4) {
#pragma unroll
                for (int e = 0; e < 16; ++e) s[i][e] = NEG; }
        }
        float mx = NEG;
#pragma unroll
        for (int i = 0; i < 5; ++i)
#pragma unroll
            for (int e = 0; e < 16; ++e) mx = fmaxf(mx, s[i][e]);
        mx = fmaxf(mx, __shfl_xor(mx, 32)); mx = fmaxf(mx, sink2);
        float sum = 0.f;
#pragma unroll
        for (int i = 0; i < 5; ++i)
#pragma unroll
            for (int e = 0; e < 16; ++e) { const float p = __builtin_amdgcn_exp2f(s[i][e] - mx); s[i][e] = p; sum += p; }
        sum += __shfl_xor(sum, 32); sum += __builtin_amdgcn_exp2f(sink2 - mx);
        const float inv = 1.0f / sum;
        v4u pw[5][2];
#pragma unroll
        for (int i = 0; i < 5; ++i) {
#pragma unroll
            for (int e = 0; e < 16; ++e) s[i][e] *= inv;
            pack_tile(pw[i], s[i]);
        }
        LAS unsigned char* st = lds + SWA_ST_OFF + I.wave * (32 * SWA_ST_RS);
#pragma unroll
        for (int db = 0; db < 2; ++db) { const f32x16 o = pv_block<5>(pw, Vl, SWA_VS, 32 * db, r, lane); stage_write(st, SWA_ST_RS, o, db, lane); }
        stage_store<8>(st, SWA_ST_RS, gate, z + (row0 + 32 * r) * DCAT + h * 64, lane);
    }
    __syncthreads();
}

constexpr int MEM_KS = 272, MEM_VS = 520;
constexpr int MEM_K_OFF = 0, MEM_V_OFF = 256 * MEM_KS;
__device__ __forceinline__ void mem_unit(ArgsP A, const Ids& I, int l, int unit, LAS unsigned char* lds) {
    const int b = unit >> 7, np = (unit >> 2) & 31, mh = unit & 3;
    const bf16* proj = (const bf16*)(A->ws + WS_PROJ); bf16* z = (bf16*)(A->ws + WS_Z);
    const bf16* mk = (const bf16*)(A->ws + WS_MKB) + (size_t)(l * 512 + b * 256) * 512 + mh * 128;
    const bf16* mv = (const bf16*)(A->ws + WS_MVB) + (size_t)(l * 512 + b * 256) * 512 + mh * 128;
    LAS unsigned char* Kl = lds + MEM_K_OFF; LAS unsigned char* Vl = lds + MEM_V_OFF;
    int tid_o = I.tid; asm volatile("" : "+v"(tid_o));
#pragma unroll
    for (int j = 0; j < 8; ++j) { const int row = (tid_o & 63) + 64 * ((tid_o >> 6) & 3), ch = 8 * (tid_o >> 8) + j;
        const v4u kv = *(const v4u*)(mk + (size_t)row * 512 + ch * 8);
        const v4u vv = *(const v4u*)(mv + (size_t)row * 512 + ch * 8);
        *(LAS v4u*)(Kl + row * MEM_KS + ch * 16) = kv;
        LAS unsigned short* vt = (LAS unsigned short*)(Vl + (ch * 8) * MEM_VS + row * 2);
        vt[0 * (MEM_VS / 2)] = (unsigned short)(vv.x & 0xffffu); vt[1 * (MEM_VS / 2)] = (unsigned short)(vv.x >> 16);
        vt[2 * (MEM_VS / 2)] = (unsigned short)(vv.y & 0xffffu); vt[3 * (MEM_VS / 2)] = (unsigned short)(vv.y >> 16);
        vt[4 * (MEM_VS / 2)] = (unsigned short)(vv.z & 0xffffu); vt[5 * (MEM_VS / 2)] = (unsigned short)(vv.z >> 16);
        vt[6 * (MEM_VS / 2)] = (unsigned short)(vv.w & 0xffffu); vt[7 * (MEM_VS / 2)] = (unsigned short)(vv.w >> 16);
    }
    __syncthreads();
    const int lane = tid_o & 63, q = lane & 31, hi = lane >> 5;
    const size_t row0 = (size_t)b * SEQ + 256 * np + 32 * I.wave;
    v4u gate[8]; gate_load<16>(gate, proj + row0 * DIN + 2560 + mh * 128, lane);
    v4u pw[8][2];
    {
        bf16x8 qf[8];
        { const bf16* qp = proj + (row0 + q) * DIN + 2048 + mh * 128 + 8 * hi;
#pragma unroll
          for (int ks = 0; ks < 8; ++ks) qf[ks] = *(const bf16x8*)(qp + 16 * ks); }
        f32x16 s[8];
#pragma unroll
        for (int i = 0; i < 8; ++i) s[i] = qk_tile<8>(Kl, MEM_KS, i, qf, lane);
        float mx = -1.0e30f;
#pragma unroll
        for (int i = 0; i < 8; ++i)
#pragma unroll
            for (int e = 0; e < 16; ++e) mx = fmaxf(mx, s[i][e]);
        mx = fmaxf(mx, __shfl_xor(mx, 32));
        float sum = 0.f;
#pragma unroll
        for (int i = 0; i < 8; ++i)
#pragma unroll
            for (int e = 0; e < 16; ++e) { const float p = __builtin_amdgcn_exp2f(s[i][e] - mx); s[i][e] = p; sum += p; }
        sum += __shfl_xor(sum, 32);
        const float inv = 1.0f / sum;
#pragma unroll
        for (int i = 0; i < 8; ++i) {
#pragma unroll
            for (int e = 0; e < 16; ++e) s[i][e] *= inv;
            pack_tile(pw[i], s[i]);
        }
    }
    __syncthreads();
    LAS unsigned char* st = Kl + I.wave * (32 * MEM_KS);
#pragma unroll
    for (int db = 0; db < 4; ++db) { const f32x16 o = pv_block<8>(pw, Vl, MEM_VS, 32 * db, 0, lane); stage_write(st, MEM_KS, o, db, lane); }
    stage_store<16>(st, MEM_KS, gate, z + row0 * DCAT + DMAIN + mh * 128, lane);
    __syncthreads();
}
constexpr int LRU_U = 0, LRU_UC = 18880, LRU_UCF = 37312, LRU_AGGW = 70080, LRU_HC = 72128, LRU_HST = 72384;
constexpr int LRU_RS = 144;
typedef float f32x2v __attribute__((ext_vector_type(2)));

struct LruConst { bf16x8 wa[4], wx[4]; float ba, bx, c1; };
__device__ __forceinline__ void lru_load_const(LruConst& C, ArgsP A, int l, int cb, int ct, int lane) {
    const int q = lane & 31, hi = lane >> 5, ch = cb * 64 + ct * 32 + q;
    const bf16* wg = (const bf16*)(A->ws + WS_WG) + ((size_t)((l * 2) * 16 + cb) * 64 + ct * 32 + q) * 64 + 8 * hi;
#pragma unroll
    for (int ks = 0; ks < 4; ++ks) { C.wa[ks] = *(const bf16x8*)(wg + 16 * ks); C.wx[ks] = *(const bf16x8*)(wg + 16 * 64 * 64 + 16 * ks); }
    C.ba = A->in[I_BA][l * DMAIN + ch]; C.bx = A->in[I_BX][l * DMAIN + ch];
    C.c1 = -8.0f * LOG2E * log1pf(expf(-A->in[I_LAM][l * DMAIN + ch]));
}
__device__ __forceinline__ void lru_gates(const LruConst& C, int rt, int ct, int lane, LAS unsigned char* lds, f32x16& a, f32x16& bt, f32x16& la) {
    const int q = lane & 31, hi = lane >> 5;
    f32x16 ga = {0.f, 0.f, 0.f, 0.f, 0.f, 0.f, 0.f, 0.f, 0.f, 0.f, 0.f, 0.f, 0.f, 0.f, 0.f, 0.f}, gx = ga;
    const LAS unsigned char* up = lds + LRU_UC + (rt * 32 + q) * LRU_RS + 16 * hi;
#pragma unroll
    for (int ks = 0; ks < 4; ++ks) {
        const bf16x8 uf = *(const LAS bf16x8*)(up + 32 * ks);
        ga = __builtin_amdgcn_mfma_f32_32x32x16_bf16(uf, C.wa[ks], ga, 0, 0, 0);
        gx = __builtin_amdgcn_mfma_f32_32x32x16_bf16(uf, C.wx[ks], gx, 0, 0, 0);
    }
    const LAS float* ucf = (const LAS float*)(lds + LRU_UCF) + (rt * 32 + 4 * hi) * 64 + ct * 32 + q;
#pragma unroll
    for (int e = 0; e < 16; ++e) {
        const float uc = ucf[((e & 3) + 8 * (e >> 2)) * 64];
        const float rg = __builtin_amdgcn_rcpf(1.0f + __builtin_amdgcn_exp2f(-(ga[e] + C.ba) * LOG2E));
        const float ig = __builtin_amdgcn_rcpf(1.0f + __builtin_amdgcn_exp2f(-(gx[e] + C.bx) * LOG2E));
        const float lav = C.c1 * rg, av = __builtin_amdgcn_exp2f(lav);
        la[e] = lav; a[e] = av; bt[e] = __builtin_amdgcn_sqrtf(fmaxf(1.0f - av * av, 0.f)) * (ig * uc);
    }
}
__device__ __forceinline__ void lru_wave_scan(const f32x16& a, const f32x16& bt, int hi, f32x16& Ap, f32x16& Hp, float (&cp)[4], float (&cq)[4], float& Pt, float& Qt) {
    float mp[4], mq[4];
#pragma unroll
    for (int g = 0; g < 4; ++g) { float P = 1.f, Q = 0.f;
#pragma unroll
        for (int i = 0; i < 4; ++i) { Q = a[4 * g + i] * Q + bt[4 * g + i]; P = a[4 * g + i] * P; Ap[4 * g + i] = P; Hp[4 * g + i] = Q; }
        mp[g] = P; mq[g] = Q; }
    float Pc = 1.f, Qc = 0.f;
#pragma unroll
    for (int g = 0; g < 4; ++g) {
        const float op = __shfl_xor(mp[g], 32), oq = __shfl_xor(mq[g], 32);
        const float p0 = hi ? op : mp[g], q0 = hi ? oq : mq[g], p1 = hi ? mp[g] : op, q1 = hi ? mq[g] : oq;
        const float Pa = p0 * Pc, Qa = p0 * Qc + q0;
        cp[g] = hi ? Pa : Pc; cq[g] = hi ? Qa : Qc;
        Pc = p1 * Pa; Qc = p1 * Qa + q1;
    }
    Pt = Pc; Qt = Qc;
}
struct LruConvW { f32x4 w[4][2], bb[2]; };
__device__ __forceinline__ void lru_load_convw(LruConvW& W, ArgsP A, int l, int cb, int tid) {
    const int c8 = tid & 7;
    const float* cw = A->in[I_CONVW] + (size_t)l * 4 * DMAIN + cb * 64 + 8 * c8;
#pragma unroll
    for (int k = 0; k < 4; ++k) { W.w[k][0] = *(const f32x4*)(cw + k * DMAIN); W.w[k][1] = *(const f32x4*)(cw + k * DMAIN + 4); }
    W.bb[0] = *(const f32x4*)(A->in[I_CONVB] + l * DMAIN + cb * 64 + 8 * c8); W.bb[1] = *(const f32x4*)(A->in[I_CONVB] + l * DMAIN + cb * 64 + 8 * c8 + 4);
}
__device__ __forceinline__ void lru_conv_prompt(const LruConvW& W, int tid, LAS unsigned char* lds) {
    const int c8 = tid & 7;
#pragma unroll
    for (int j = 0; j < 2; ++j) { const int t = (tid >> 3) + 64 * j;
        f32x4 o0 = W.bb[0], o1 = W.bb[1];
#pragma unroll
        for (int k = 0; k < 4; ++k) { const v4u uv = *(const LAS v4u*)(lds + LRU_U + (t + k) * LRU_RS + c8 * 16);
            const f32x4 u0 = {__builtin_bit_cast(float, uv.x << 16), __builtin_bit_cast(float, uv.x & 0xffff0000u), __builtin_bit_cast(float, uv.y << 16), __builtin_bit_cast(float, uv.y & 0xffff0000u)};
            const f32x4 u1 = {__builtin_bit_cast(float, uv.z << 16), __builtin_bit_cast(float, uv.z & 0xffff0000u), __builtin_bit_cast(float, uv.w << 16), __builtin_bit_cast(float, uv.w & 0xffff0000u)};
            o0 += u0 * W.w[k][0]; o1 += u1 * W.w[k][1]; }
        v4u pk; pk.x = pk2(o0[0], o0[1]); pk.y = pk2(o0[2], o0[3]); pk.z = pk2(o1[0], o1[1]); pk.w = pk2(o1[2], o1[3]);
        *(LAS v4u*)(lds + LRU_UC + t * LRU_RS + c8 * 16) = pk;
        LAS f32x4* uf = (LAS f32x4*)(lds + LRU_UCF + t * 256 + c8 * 32); uf[0] = o0; uf[1] = o1; }
}
template <int PASS> __device__ __forceinline__ void lru_prompt_pass(ArgsP A, const Ids& I, int l, LAS unsigned char* lds) {
    const int vcu = I.gw >> 3, chain = vcu >> 3, sg = vcu & 7, b = chain >> 4, cb = chain & 15;
    const bf16* proj = (const bf16*)(A->ws + WS_PROJ); bf16* z = (bf16*)(A->ws + WS_Z);
    f32x2v* agg = (f32x2v*)(A->ws + WS_AGG) + (size_t)l * 256 * 64;
    LAS float* HC = (LAS float*)(lds + LRU_HC); LAS f32x2v* AGGW = (LAS f32x2v*)(lds + LRU_AGGW);
    int tid = I.tid; asm volatile("" : "+v"(tid));
    const int lane = tid & 63, hi = lane >> 5, rt = I.wave >> 1, ct = I.wave & 1;
    LruConst C; lru_load_const(C, A, l, cb, ct, lane);
    LruConvW W; lru_load_convw(W, A, l, cb, tid);
    float Pseg = 1.f, Qseg = 0.f;
    v4u un[3];
#define LRU_FETCH(c_) do { const long r0_ = (long)b * SEQ + 128 * (c_); _Pragma("unroll") for (int j = 0; j < 3; ++j) { const int id = tid + 512 * j; un[j] = (v4u){0u, 0u, 0u, 0u}; \
        if (id < 131 * 8) { const int row = id >> 3, c8 = id & 7; if ((c_) > 0 || row >= 3) un[j] = *(const v4u*)(proj + (size_t)(r0_ - 3 + row) * DIN + cb * 64 + c8 * 8); } } } while (0)
    LRU_FETCH(sg * 8);
    if (PASS == 2) {
        if (I.wave == 0) {
            unsigned* fl = (unsigned*)(A->ws + WS_CTL) + CW_LRUF + (size_t)(l * 256 + chain * 8) * 64;
            unsigned spins = 0;
            while (true) { const unsigned f = lane < sg ? __hip_atomic_load(fl + lane * 64, __ATOMIC_RELAXED, __HIP_MEMORY_SCOPE_AGENT) : 1u;
                if (__all(f != 0u) || ++spins > (1u << 22)) break; __builtin_amdgcn_s_sleep(2); }
            __builtin_amdgcn_fence(__ATOMIC_ACQUIRE, "agent");
            asm volatile("s_waitcnt vmcnt(0)" ::: "memory");
            float h = 0.f;
            for (int s2 = 0; s2 < sg; ++s2) { const f32x2v m = agg[(size_t)(chain * 8 + s2) * 64 + lane]; h = m.x * h + m.y; }
            HC[lane] = h; }
    }
#pragma unroll 1
    for (int ci = 0; ci < 8; ++ci) {
        const int c = sg * 8 + ci;
        const long row0 = (long)b * SEQ + 128 * c;
#pragma unroll
        for (int j = 0; j < 3; ++j) { const int id = tid + 512 * j;
            if (id < 131 * 8) { const int row = id >> 3, c8 = id & 7; const v4u v = un[j];
                *(LAS v4u*)(lds + LRU_U + row * LRU_RS + c8 * 16) = v;
                if (PASS == 1 && c == 63 && row >= 128) { float* oc = A->out + O_CP + ((size_t)(l * NB + b) * 3 + (row - 128)) * DMAIN + cb * 64 + c8 * 8;
                    *(f32x4*)oc = (f32x4){__builtin_bit_cast(float, v.x << 16), __builtin_bit_cast(float, v.x & 0xffff0000u), __builtin_bit_cast(float, v.y << 16), __builtin_bit_cast(float, v.y & 0xffff0000u)};
                    *(f32x4*)(oc + 4) = (f32x4){__builtin_bit_cast(float, v.z << 16), __builtin_bit_cast(float, v.z & 0xffff0000u), __builtin_bit_cast(float, v.w << 16), __builtin_bit_cast(float, v.w & 0xffff0000u)}; } } }
        if (ci < 7) LRU_FETCH(c + 1);
        v4u gate[2];
        if (PASS == 2) { const bf16* gp = proj + (size_t)(row0 + (tid >> 3)) * DIN + DMAIN + cb * 64 + (tid & 7) * 8; gate[0] = *(const v4u*)gp; gate[1] = *(const v4u*)(gp + (size_t)64 * DIN); }
        __syncthreads();
        lru_conv_prompt(W, tid, lds);
        __syncthreads();
        f32x16 a, bt, la; lru_gates(C, rt, ct, lane, lds, a, bt, la);
        if (PASS == 1) {
            unsigned* lab = (unsigned*)(A->ws + WS_LAB) + (size_t)l * (16u << 20) + ((size_t)((chain * 64 + c) * 8 + I.wave) * 16) * 64 + lane;
#pragma unroll
            for (int e = 0; e < 16; ++e) __builtin_nontemporal_store(cvtpk(la[e], bt[e]), lab + e * 64); }
        f32x16 Ap, Hp; float cp[4], cq[4], Pt, Qt;
        lru_wave_scan(a, bt, hi, Ap, Hp, cp, cq, Pt, Qt);
        if (hi == 0) AGGW[rt * 64 + ct * 32 + (lane & 31)] = (f32x2v){Pt, Qt};
        __syncthreads();
        if (PASS == 1) {
            if (I.wave == 0) {
#pragma unroll
                for (int r2 = 0; r2 < 4; ++r2) { const f32x2v m = AGGW[r2 * 64 + lane]; Qseg = m.x * Qseg + m.y; Pseg = m.x * Pseg; } }
        } else {
            float hin = HC[ct * 32 + (lane & 31)];
            for (int r2 = 0; r2 < rt; ++r2) { const f32x2v m = AGGW[r2 * 64 + ct * 32 + (lane & 31)]; hin = m.x * hin + m.y; }
            f32x16 h;
#pragma unroll
            for (int g = 0; g < 4; ++g) { const float hs = cp[g] * hin + cq[g];
#pragma unroll
                for (int i = 0; i < 4; ++i) h[4 * g + i] = Ap[4 * g + i] * hs + Hp[4 * g + i]; }
            stage_write(lds + LRU_HST + (32 * rt) * LRU_RS, LRU_RS, h, ct, lane);
            __syncthreads();
            if (rt == 3 && hi == 1) { HC[ct * 32 + (lane & 31)] = h[15];
                if (c == 63) A->out[O_HP + (size_t)(l * NB + b) * DMAIN + cb * 64 + ct * 32 + (lane & 31)] = h[15]; }
            { const LAS unsigned char* sp = lds + LRU_HST + (tid >> 3) * LRU_RS + (tid & 7) * 16; bf16* zp = z + (size_t)(row0 + (tid >> 3)) * DCAT + cb * 64 + (tid & 7) * 8;
              *(v4u*)zp = mul_bf16x8(*(const LAS v4u*)sp, gate[0]); *(v4u*)(zp + (size_t)64 * DCAT) = mul_bf16x8(*(const LAS v4u*)(sp + 64 * LRU_RS), gate[1]); }
        }
    }
#undef LRU_FETCH
    if (PASS == 1) { if (I.wave == 0) {
            agg[(size_t)(chain * 8 + sg) * 64 + lane] = (f32x2v){Pseg, Qseg};
            asm volatile("s_waitcnt vmcnt(0)" ::: "memory");
            if (lane == 0) { __builtin_amdgcn_fence(__ATOMIC_RELEASE, "agent"); asm volatile("s_waitcnt vmcnt(0)" ::: "memory");
                __hip_atomic_store((unsigned*)(A->ws + WS_CTL) + CW_LRUF + (size_t)(l * 256 + chain * 8 + sg) * 64, 1u, __ATOMIC_RELAXED, __HIP_MEMORY_SCOPE_AGENT); } } }
    __syncthreads();
}
__device__ __forceinline__ void lru_prompt_pass2(ArgsP A, const Ids& I, int l, LAS unsigned char* lds) {
    const int vcu = I.gw >> 3, chain = vcu >> 3, sg = vcu & 7, b = chain >> 4, cb = chain & 15;
    const bf16* proj = (const bf16*)(A->ws + WS_PROJ); bf16* z = (bf16*)(A->ws + WS_Z);
    const f32x2v* agg = (const f32x2v*)(A->ws + WS_AGG) + (size_t)l * 256 * 64;
    LAS float* HC = (LAS float*)(lds + LRU_HC); LAS f32x2v* AGGW = (LAS f32x2v*)(lds + LRU_AGGW);
    int tid = I.tid; asm volatile("" : "+v"(tid));
    const int lane = tid & 63, hi = lane >> 5, rt = I.wave >> 1, ct = I.wave & 1;
    const unsigned* lab0 = (const unsigned*)(A->ws + WS_LAB) + (size_t)l * (16u << 20) + ((size_t)((chain * 64 + sg * 8) * 8 + I.wave) * 16) * 64 + lane;
    unsigned wv[2][16]; v4u gate[2][2];
#define LRU2_FETCH(slot_, ci_) do { _Pragma("unroll") for (int e = 0; e < 16; ++e) wv[slot_][e] = __builtin_nontemporal_load(lab0 + (size_t)(ci_) * (8 * 16 * 64) + e * 64); \
        const bf16* gp_ = proj + (size_t)((long)b * SEQ + 128 * (sg * 8 + (ci_)) + (tid >> 3)) * DIN + DMAIN + cb * 64 + (tid & 7) * 8; gate[slot_][0] = *(const v4u*)gp_; gate[slot_][1] = *(const v4u*)(gp_ + (size_t)64 * DIN); } while (0)
    if (I.wave == 0) {
        unsigned* fl = (unsigned*)(A->ws + WS_CTL) + CW_LRUF + (size_t)(l * 256 + chain * 8) * 64;
        unsigned spins = 0;
        while (true) { const unsigned f = lane < sg ? __hip_atomic_load(fl + lane * 64, __ATOMIC_RELAXED, __HIP_MEMORY_SCOPE_AGENT) : 1u;
            if (__all(f != 0u) || ++spins > (1u << 22)) break; __builtin_amdgcn_s_sleep(2); }
        __builtin_amdgcn_fence(__ATOMIC_ACQUIRE, "agent");
        asm volatile("s_waitcnt vmcnt(0)" ::: "memory");
        float h = 0.f;
        for (int s2 = 0; s2 < sg; ++s2) { const f32x2v m = agg[(size_t)(chain * 8 + s2) * 64 + lane]; h = m.x * h + m.y; }
        HC[lane] = h; }
    LRU2_FETCH(0, 0);
#pragma unroll
    for (int ci = 0; ci < 8; ++ci) {
        const int c = sg * 8 + ci; const long row0 = (long)b * SEQ + 128 * c;
        if (ci < 7) LRU2_FETCH((ci + 1) & 1, ci + 1);
        __builtin_amdgcn_sched_barrier(0);
        f32x16 a, bt;
#pragma unroll
        for (int e = 0; e < 16; ++e) { const unsigned w = wv[ci & 1][e]; a[e] = __builtin_amdgcn_exp2f(__builtin_bit_cast(float, w << 16)); bt[e] = __builtin_bit_cast(float, w & 0xffff0000u); }
        f32x16 Ap, Hp; float cp[4], cq[4], Pt, Qt;
        lru_wave_scan(a, bt, hi, Ap, Hp, cp, cq, Pt, Qt);
        if (hi == 0) AGGW[rt * 64 + ct * 32 + (lane & 31)] = (f32x2v){Pt, Qt};
        __syncthreads();
        float hin = HC[ct * 32 + (lane & 31)];
        for (int r2 = 0; r2 < rt; ++r2) { const f32x2v m = AGGW[r2 * 64 + ct * 32 + (lane & 31)]; hin = m.x * hin + m.y; }
        f32x16 h;
#pragma unroll
        for (int g = 0; g < 4; ++g) { const float hs = cp[g] * hin + cq[g];
#pragma unroll
            for (int i = 0; i < 4; ++i) h[4 * g + i] = Ap[4 * g + i] * hs + Hp[4 * g + i]; }
        stage_write(lds + LRU_HST + (32 * rt) * LRU_RS, LRU_RS, h, ct, lane);
        __syncthreads();
        if (rt == 3 && hi == 1) { HC[ct * 32 + (lane & 31)] = h[15];
            if (c == 63) A->out[O_HP + (size_t)(l * NB + b) * DMAIN + cb * 64 + ct * 32 + (lane & 31)] = h[15]; }
        { const LAS unsigned char* sp = lds + LRU_HST + (tid >> 3) * LRU_RS + (tid & 7) * 16; bf16* zp = z + (size_t)(row0 + (tid >> 3)) * DCAT + cb * 64 + (tid & 7) * 8;
          *(v4u*)zp = mul_bf16x8(*(const LAS v4u*)sp, gate[ci & 1][0]); *(v4u*)(zp + (size_t)64 * DCAT) = mul_bf16x8(*(const LAS v4u*)(sp + 64 * LRU_RS), gate[ci & 1][1]); }
    }
#undef LRU2_FETCH
    __syncthreads();
}
__device__ __forceinline__ void lru_sample_item(ArgsP A, const Ids& I, int l, int item, LAS unsigned char* lds) {
    const int cb = item >> 2, rq = item & 3;
    const bf16* proj = (const bf16*)(A->ws + WS_PROJ); bf16* z = (bf16*)(A->ws + WS_Z);
    int tid = I.tid; asm volatile("" : "+v"(tid));
    const int lane = tid & 63, hi = lane >> 5, ct = I.wave & 1;
    const int chn = cb * 64 + ct * 32 + (lane & 31);
    float h0[16]; bf16 gz[16];
    LruConst C;
    if (I.wave < 2) {
        lru_load_const(C, A, l, cb, ct, lane);
#pragma unroll
        for (int e = 0; e < 16; ++e) { const int sb = 32 * rq + crow(e, hi); h0[e] = A->in[I_STH][(size_t)(l * MS + sb) * DMAIN + chn]; gz[e] = proj[(size_t)(MP + sb) * DIN + DMAIN + chn]; }
    }
    if (tid < 256) {
        const int c8 = tid & 7, sb = 32 * rq + (tid >> 3);
        const float* cw = A->in[I_CONVW] + (size_t)l * 4 * DMAIN + cb * 64 + 8 * c8;
        const float* sc = A->in[I_STC] + (size_t)(l * MS + sb) * 3 * DMAIN + cb * 64 + 8 * c8;
        float* oc = A->out + O_CS + (size_t)(l * MS + sb) * 3 * DMAIN + cb * 64 + 8 * c8;
        const v4u uv = *(const v4u*)(proj + (size_t)(MP + sb) * DIN + cb * 64 + c8 * 8);
        f32x4 x[4][2], w[4][2];
#pragma unroll
        for (int k = 0; k < 3; ++k) { x[k][0] = *(const f32x4*)(sc + k * DMAIN); x[k][1] = *(const f32x4*)(sc + k * DMAIN + 4); }
#pragma unroll
        for (int k = 0; k < 4; ++k) { w[k][0] = *(const f32x4*)(cw + k * DMAIN); w[k][1] = *(const f32x4*)(cw + k * DMAIN + 4); }
        f32x4 o0 = *(const f32x4*)(A->in[I_CONVB] + l * DMAIN + cb * 64 + 8 * c8), o1 = *(const f32x4*)(A->in[I_CONVB] + l * DMAIN + cb * 64 + 8 * c8 + 4);
        x[3][0] = (f32x4){__builtin_bit_cast(float, uv.x << 16), __builtin_bit_cast(float, uv.x & 0xffff0000u), __builtin_bit_cast(float, uv.y << 16), __builtin_bit_cast(float, uv.y & 0xffff0000u)};
        x[3][1] = (f32x4){__builtin_bit_cast(float, uv.z << 16), __builtin_bit_cast(float, uv.z & 0xffff0000u), __builtin_bit_cast(float, uv.w << 16), __builtin_bit_cast(float, uv.w & 0xffff0000u)};
#pragma unroll
        for (int k = 0; k < 4; ++k) { o0 += x[k][0] * w[k][0]; o1 += x[k][1] * w[k][1]; }
#pragma unroll
        for (int k = 0; k < 3; ++k) { *(f32x4*)(oc + k * DMAIN) = x[k + 1][0]; *(f32x4*)(oc + k * DMAIN + 4) = x[k + 1][1]; }
        v4u pk; pk.x = pk2(o0[0], o0[1]); pk.y = pk2(o0[2], o0[3]); pk.z = pk2(o1[0], o1[1]); pk.w = pk2(o1[2], o1[3]);
        *(LAS v4u*)(lds + LRU_UC + (tid >> 3) * LRU_RS + c8 * 16) = pk;
        LAS f32x4* uf = (LAS f32x4*)(lds + LRU_UCF + (tid >> 3) * 256 + c8 * 32); uf[0] = o0; uf[1] = o1;
    }
    __syncthreads();
    if (I.wave < 2) {
        f32x16 a, bt, la_; lru_gates(C, 0, ct, lane, lds, a, bt, la_);
#pragma unroll
        for (int e = 0; e < 16; ++e) { const int sb = 32 * rq + crow(e, hi); const float h = a[e] * h0[e] + bt[e];
            A->out[O_HS + (size_t)(l * MS + sb) * DMAIN + chn] = h; z[(size_t)(MP + sb) * DCAT + chn] = (bf16)f2bf(h * bf2f(gz[e])); }
    }
    __syncthreads();
}
constexpr int SM_SC = 0, SM_RED = 2048;
struct SmemAddr { const f32x4* kp; const f32x4* vp; const bf16* qp; const bf16* gp; bf16* zp; };
__device__ __forceinline__ SmemAddr smem_addr(ArgsP A, int l, int pair, int w, int half, int ck) {
    const int sb = pair >> 2, mh = pair & 3; SmemAddr R;
    const size_t base = (((size_t)(l * MS + sb) * NMEM) * MEMH + mh) * MEMHD + (size_t)(32 * w + half) * (MEMH * MEMHD);
    R.kp = (const f32x4*)(A->in[I_CMK] + base) + ck; R.vp = (const f32x4*)(A->in[I_CMV] + base) + ck;
    const bf16* prow = (const bf16*)(A->ws + WS_PROJ) + (size_t)(MP + sb) * DIN;
    R.qp = prow + 2048 + mh * 128; R.gp = prow + 2560 + mh * 128; R.zp = (bf16*)(A->ws + WS_Z) + (size_t)(MP + sb) * DCAT + DMAIN + mh * 128;
    return R;
}
__device__ __forceinline__ f32x4 smem_q(const SmemAddr& R, int ck) {
    const unsigned long long qq = *(const unsigned long long*)(R.qp + 4 * ck); const unsigned lo = (unsigned)qq, hi = (unsigned)(qq >> 32);
    return (f32x4){__builtin_bit_cast(float, lo << 16), __builtin_bit_cast(float, lo & 0xffff0000u), __builtin_bit_cast(float, hi << 16), __builtin_bit_cast(float, hi & 0xffff0000u)};
}
#define SMEM_LOAD16(dst, src) do { _Pragma("unroll") for (int i = 0; i < 16; ++i) dst[i] = __builtin_nontemporal_load((src) + (size_t)i * (2 * MEMH * MEMHD / 4)); } while (0)
__device__ __forceinline__ void smem_scores(const f32x4 (&kf)[16], const f32x4 qv, LAS float* sc, int w, int half, int ck) {
#pragma unroll
    for (int i = 0; i < 16; ++i) {
        float s = (kf[i][0] * qv[0] + kf[i][1] * qv[1]) + (kf[i][2] * qv[2] + kf[i][3] * qv[3]);
        s += __shfl_xor(s, 1); s += __shfl_xor(s, 2); s += __shfl_xor(s, 4); s += __shfl_xor(s, 8); s += __shfl_xor(s, 16);
        if (ck == 0) sc[32 * w + 2 * i + half] = s;
    }
}
__device__ __forceinline__ void smem_pv(const f32x4 (&vf)[16], const LAS float* sc, LAS float* red, int w, int half, int ck, int lane) {
    float mx, inv;
    { const float s0 = sc[lane], s1 = sc[lane + 64], s2 = sc[lane + 128], s3 = sc[lane + 192];
      mx = wave_max(fmaxf(fmaxf(s0, s1), fmaxf(s2, s3)));
      const float e = (__builtin_amdgcn_exp2f(s0 - mx) + __builtin_amdgcn_exp2f(s1 - mx)) + (__builtin_amdgcn_exp2f(s2 - mx) + __builtin_amdgcn_exp2f(s3 - mx));
      inv = 1.0f / wave_sum(e); }
    f32x4 acc = {0.f, 0.f, 0.f, 0.f};
#pragma unroll
    for (int i = 0; i < 16; ++i) { const float p = __builtin_amdgcn_exp2f(sc[32 * w + 2 * i + half] - mx) * inv; acc += vf[i] * p; }
#pragma unroll
    for (int j = 0; j < 4; ++j) acc[j] += __shfl_xor(acc[j], 32);
    if (half == 0) *(LAS f32x4*)(red + w * 128 + 4 * ck) = acc;
}
__device__ __forceinline__ void smem_out(const SmemAddr& R, const LAS float* red, int tid) {
    if (tid < 128) { float o = 0.f;
#pragma unroll
        for (int ww = 0; ww < 8; ++ww) o += red[ww * 128 + tid];
        R.zp[tid] = (bf16)f2bf(o * bf2f(R.gp[tid])); }
}
__device__ __forceinline__ void smem_two(ArgsP A, const Ids& I, int l, int pairA, int pairB, LAS unsigned char* lds) {
    int tid = I.tid; asm volatile("" : "+v"(tid));
    const int lane = tid & 63, half = lane >> 5, ck = lane & 31, w = I.wave;
    LAS float* sc = (LAS float*)(lds + SM_SC); LAS float* red = (LAS float*)(lds + SM_RED);
    const SmemAddr RA = smem_addr(A, l, pairA, w, half, ck), RB = smem_addr(A, l, pairB, w, half, ck);
    const f32x4 qa = smem_q(RA, ck), qb = smem_q(RB, ck);
    __builtin_amdgcn_sched_barrier(0);
    f32x4 kf[16], vf[16];
    SMEM_LOAD16(kf, RA.kp); SMEM_LOAD16(vf, RA.vp);
    __builtin_amdgcn_sched_barrier(0);
    smem_scores(kf, qa, sc, w, half, ck);
    __builtin_amdgcn_sched_barrier(0);
    SMEM_LOAD16(kf, RB.kp);
    __builtin_amdgcn_sched_barrier(0);
    __syncthreads();
    smem_pv(vf, sc, red, w, half, ck, lane);
    __builtin_amdgcn_sched_barrier(0);
    SMEM_LOAD16(vf, RB.vp);
    __builtin_amdgcn_sched_barrier(0);
    __syncthreads();
    smem_out(RA, red, tid);
    smem_scores(kf, qb, sc + 256, w, half, ck);
    __syncthreads();
    smem_pv(vf, sc + 256, red, w, half, ck, lane);
    __syncthreads();
    smem_out(RB, red, tid);
    __syncthreads();
}
__device__ __forceinline__ void sswa_task(ArgsP A, int l, int task, int lane) {
    const int sb = task >> 4, h = task & 15, kvh = h >> 3, grp = lane >> 4, c = lane & 15;
    const bf16* proj = (const bf16*)(A->ws + WS_PROJ); bf16* z = (bf16*)(A->ws + WS_Z);
    const size_t r = (size_t)MP + sb;
    const int p0 = c < 8 ? 8 * c : 8 * (c - 8) + 4;
    f32x4 qv, knew, vnew;
    { const unsigned long long qq = *(const unsigned long long*)(proj + r * DIN + h * 64 + p0); const unsigned lo = (unsigned)qq, hi = (unsigned)(qq >> 32);
      qv = (f32x4){__builtin_bit_cast(float, lo << 16), __builtin_bit_cast(float, lo & 0xffff0000u), __builtin_bit_cast(float, hi << 16), __builtin_bit_cast(float, hi & 0xffff0000u)}; }
    { const unsigned long long kk = *(const unsigned long long*)((const bf16*)(A->ws + WS_KB) + r * 128 + kvh * 64 + p0); const unsigned lo = (unsigned)kk, hi = (unsigned)(kk >> 32);
      knew = (f32x4){__builtin_bit_cast(float, lo << 16), __builtin_bit_cast(float, lo & 0xffff0000u), __builtin_bit_cast(float, hi << 16), __builtin_bit_cast(float, hi & 0xffff0000u)}; }
    { const unsigned long long vv = *(const unsigned long long*)((const bf16*)(A->ws + WS_VB) + r * 128 + kvh * 64 + 4 * c); const unsigned lo = (unsigned)vv, hi = (unsigned)(vv >> 32);
      vnew = (f32x4){__builtin_bit_cast(float, lo << 16), __builtin_bit_cast(float, lo & 0xffff0000u), __builtin_bit_cast(float, hi << 16), __builtin_bit_cast(float, hi & 0xffff0000u)}; }
    const float sink2 = A->in[I_SINKS][(l - N_A) * NHEADS + h] * LOG2E;
    const f32x4* kp = (const f32x4*)(A->in[I_CWK] + ((size_t)(sb * WIN + grp) * NKV + kvh) * HD) + c;
    const f32x4* vp = (const f32x4*)(A->in[I_CWV] + ((size_t)(sb * WIN + grp) * NKV + kvh) * HD) + c;
    __builtin_amdgcn_sched_barrier(0);
    float s[32];
    { f32x4 kk[32];
#pragma unroll
      for (int i = 0; i < 32; ++i) kk[i] = __builtin_nontemporal_load(kp + (size_t)i * (4 * NKV * HD / 4));
      __builtin_amdgcn_sched_barrier(0);
#pragma unroll
      for (int i = 0; i < 32; ++i) { float t = (kk[i][0] * qv[0] + kk[i][1] * qv[1]) + (kk[i][2] * qv[2] + kk[i][3] * qv[3]);
          t += __shfl_xor(t, 1); t += __shfl_xor(t, 2); t += __shfl_xor(t, 4); t += __shfl_xor(t, 8);
          s[i] = t; } }
    if (grp == 0) s[0] = -1.0e30f;
    float sn = (knew[0] * qv[0] + knew[1] * qv[1]) + (knew[2] * qv[2] + knew[3] * qv[3]);
    sn += __shfl_xor(sn, 1); sn += __shfl_xor(sn, 2); sn += __shfl_xor(sn, 4); sn += __shfl_xor(sn, 8);
    float mx = fmaxf(sn, sink2);
#pragma unroll
    for (int i = 0; i < 32; ++i) mx = fmaxf(mx, s[i]);
    mx = fmaxf(mx, __shfl_xor(mx, 16)); mx = fmaxf(mx, __shfl_xor(mx, 32));
    float sum = 0.f; f32x4 acc = {0.f, 0.f, 0.f, 0.f};
#pragma unroll
    for (int hb = 0; hb < 2; ++hb) { f32x4 vv[16];
#pragma unroll
        for (int i = 0; i < 16; ++i) vv[i] = __builtin_nontemporal_load(vp + (size_t)(16 * hb + i) * (4 * NKV * HD / 4));
        __builtin_amdgcn_sched_barrier(0);
#pragma unroll
        for (int i = 0; i < 16; ++i) { const float p = __builtin_amdgcn_exp2f(s[16 * hb + i] - mx); sum += p; acc += vv[i] * p; }
        __builtin_amdgcn_sched_barrier(0); }
    sum += __shfl_xor(sum, 16); sum += __shfl_xor(sum, 32);
#pragma unroll
    for (int j = 0; j < 4; ++j) { acc[j] += __shfl_xor(acc[j], 16); acc[j] += __shfl_xor(acc[j], 32); }
    const float pn = __builtin_amdgcn_exp2f(sn - mx);
    const float den = sum + pn + __builtin_amdgcn_exp2f(sink2 - mx);
    acc += vnew * pn;
    if (lane < 16) { const float inv = 1.0f / den;
        const unsigned long long gg = *(const unsigned long long*)(proj + r * DIN + DMAIN + h * 64 + 4 * c); const unsigned lo = (unsigned)gg, hi = (unsigned)(gg >> 32);
        const unsigned o0 = pk2(acc[0] * inv * __builtin_bit_cast(float, lo << 16), acc[1] * inv * __builtin_bit_cast(float, lo & 0xffff0000u));
        const unsigned o1 = pk2(acc[2] * inv * __builtin_bit_cast(float, hi << 16), acc[3] * inv * __builtin_bit_cast(float, hi & 0xffff0000u));
        *(unsigned long long*)(z + r * DCAT + h * 64 + 4 * c) = (unsigned long long)o0 | ((unsigned long long)o1 << 32); }
}
template <int K> __device__ __forceinline__ f32x4 skinny_core(const bf16* a0, const bf16* b0, int wave, int lane, LAS unsigned char* lds) {
    constexpr int KS = K / 8 / 32;
    const int rl = lane & 15, kq = lane >> 4, kb = wave * (K / 8) + 8 * kq;
    bf16x8 af[4][KS], bfr[2][KS];
#pragma unroll
    for (int cg = 0; cg < 2; ++cg)
#pragma unroll
        for (int ks = 0; ks < KS; ++ks) bfr[cg][ks] = *(const bf16x8*)(b0 + (size_t)(16 * cg + rl) * K + kb + 32 * ks);
#pragma unroll
    for (int rg = 0; rg < 4; ++rg)
#pragma unroll
        for (int ks = 0; ks < KS; ++ks) af[rg][ks] = *(const bf16x8*)(a0 + (size_t)(16 * rg + rl) * K + kb + 32 * ks);
    __builtin_amdgcn_sched_barrier(0);
    LAS f32x4* part = (LAS f32x4*)lds;
#pragma unroll
    for (int rg = 0; rg < 4; ++rg)
#pragma unroll
        for (int cg = 0; cg < 2; ++cg) { f32x4 acc = {0.f, 0.f, 0.f, 0.f};
#pragma unroll
            for (int ks = 0; ks < KS; ++ks) acc = __builtin_amdgcn_mfma_f32_16x16x32_bf16(bfr[cg][ks], af[rg][ks], acc, 0, 0, 0);
            part[(wave * 8 + rg * 2 + cg) * 64 + lane] = acc; }
    __syncthreads();
    f32x4 r = part[(0 * 8 + wave) * 64 + lane];
#pragma unroll
    for (int ws = 1; ws < 8; ++ws) r += part[(ws * 8 + wave) * 64 + lane];
    __syncthreads();
    return r;
}
__device__ __forceinline__ void skinny_in_item(ArgsP A, const Ids& I, int l, int item, LAS unsigned char* lds) {
    unsigned char* ws = A->ws;
    int tid = I.tid; asm volatile("" : "+v"(tid));
    const int lane = tid & 63, rl = lane & 15, kq = lane >> 4, rh = item & 1, c0 = (item >> 1) * 32;
    const bf16* xb = (const bf16*)(ws + WS_XB); const bf16* wt = (const bf16*)(ws + WS_WIN + l * WIN_STRIDE);
    const int rg = I.wave >> 1, cg = I.wave & 1;
    const int r = MP + 64 * rh + 16 * rg + rl, c = c0 + 16 * cg + 4 * kq, sb = r - MP;
    const int kind = c0 < 1024 ? (l >= N_A ? 1 : 0) : c0 < 2048 ? 2 : c0 < 2560 ? 3 : c0 < 3072 ? 2 : c0 < 3200 ? 4 : 5;
    const float rsq_ = ((const float*)(ws + WS_ROWSQ))[(size_t)l * MPAD + r];
    f32x4 cs = {1.f, 1.f, 1.f, 1.f}, sn = {0.f, 0.f, 0.f, 0.f};
    if (kind == 1 || kind == 4) { const float* rp = (const float*)(ws + WS_ROPE) + (size_t)SEQ * 64 + 4 * ((c & 63) >> 3); cs = *(const f32x4*)rp; sn = *(const f32x4*)(rp + 32); }
    f32x4 v = skinny_core<DM>(xb + (size_t)(MP + 64 * rh) * DM, wt + (size_t)c0 * DM, I.wave, lane, lds);
    const float rs = __builtin_amdgcn_rsqf(rsq_ * (1.0f / 1024.0f) + EPS);
    v = v * rs;
    if (kind == 1 || kind == 4) {
        const int p = c & 63, n = (p >> 2) & 1, g = p >> 3;
        f32x4 o;
#pragma unroll
        for (int i = 0; i < 4; ++i) o[i] = __shfl_xor(v[i], 16);
        v = n == 0 ? v * cs - o * sn : v * cs + o * sn;
        if (kind == 1) v = v * QSCALE;
        else { *(f32x4*)(A->out + O_WKS + ((size_t)(sb * WIN + (WIN - 1)) * 2 + ((c - 3072) >> 6)) * 64 + 32 * n + 4 * g) = v; }
    } else if (kind == 2) {
#pragma unroll
        for (int i = 0; i < 4; ++i) v[i] = pg8::silu_f(v[i]);
    } else if (kind == 3) v = v * MSCALE;
    else if (kind == 5) *(f32x4*)(A->out + O_WVS + (size_t)(sb * WIN + (WIN - 1)) * 128 + (c - 3200)) = v;
    const unsigned long long w = (unsigned long long)pk2(v[0], v[1]) | ((unsigned long long)pk2(v[2], v[3]) << 32);
    bf16* dst = kind == 4 ? (bf16*)(ws + WS_KB) + (size_t)r * 128 + (c - 3072) : kind == 5 ? (bf16*)(ws + WS_VB) + (size_t)r * 128 + (c - 3200) : (bf16*)(ws + WS_PROJ) + (size_t)r * DIN + c;
    *(unsigned long long*)dst = w;
}
__device__ __forceinline__ void skinny_out_item(ArgsP A, const Ids& I, int l, int item, LAS unsigned char* lds) {
    unsigned char* ws = A->ws;
    int tid = I.tid; asm volatile("" : "+v"(tid));
    const int lane = tid & 63, rl = lane & 15, kq = lane >> 4, rh = item & 1, c0 = (item >> 1) * 32;
    const bf16* zb = (const bf16*)(ws + WS_Z); const bf16* wt = (const bf16*)(ws + WS_WOUT + l * WOUT_STRIDE);
    const int rg = I.wave >> 1, cg = I.wave & 1;
    const int r = MP + 64 * rh + 16 * rg + rl, c = c0 + 16 * cg + 4 * kq;
    bf16* xbp = (bf16*)(ws + WS_XB) + (size_t)r * DM + c;
    const unsigned long long xw_ = *(const unsigned long long*)xbp;
    const f32x4 acc = skinny_core<DCAT>(zb + (size_t)(MP + 64 * rh) * DCAT, wt + (size_t)c0 * DCAT, I.wave, lane, lds);
    f32x4 xo;
    { const unsigned long long w = xw_; const unsigned lo = (unsigned)w, hi = (unsigned)(w >> 32);
      xo = (f32x4){__builtin_bit_cast(float, lo << 16), __builtin_bit_cast(float, lo & 0xffff0000u), __builtin_bit_cast(float, hi << 16), __builtin_bit_cast(float, hi & 0xffff0000u)}; }
    const f32x4 xn = xo + acc;
    *(unsigned long long*)xbp = (unsigned long long)pk2(xn[0], xn[1]) | ((unsigned long long)pk2(xn[2], xn[3]) << 32);
    float ss = (xn[0] * xn[0] + xn[1] * xn[1]) + (xn[2] * xn[2] + xn[3] * xn[3]);
    ss += __shfl_xor(ss, 16); ss += __shfl_xor(ss, 32);
    if (kq == 0) atomicAdd((float*)(ws + WS_ROWSQ) + (size_t)(l + 1) * MPAD + r, ss);
}
#ifndef MK_PER_PHASE
#define MK_PER_PHASE 0
#endif
constexpr int NPHASES = 1 + N_A * 3 + (DEPTH - N_A) * 3;

enum { K_P0 = 0, K_MEM, K_IN, K_LRU1, K_LRU2  , K_ATT, K_OUT, K_FINAL };
__device__ __forceinline__ void decode_phase(int ph, int& kind, int& l) {
    l = 0;
    if (ph == 0) { kind = K_P0; return; }
    int q = ph - 1;
    if (q < N_A * 3) { l = q / 3; const int k = q - l * 3; kind = k == 0 ? K_IN : k == 1 ? K_LRU1 : K_OUT; return; }
    q -= N_A * 3;
    if (q < (DEPTH - N_A) * 3) { const int j = q / 3, k = q - j * 3; l = N_A + j; kind = k == 0 ? K_IN : k == 1 ? K_ATT : K_OUT; return; }
    kind = K_FINAL;
}

__global__ void __launch_bounds__(NWAVES * 64, 2) mk_fwd(Args args) {
    extern __shared__ __attribute__((aligned(16))) unsigned char lds_raw[];
    LAS unsigned char* lds = (LAS unsigned char*)lds_raw;
    for (int u = threadIdx.x; u < (LDS_BYTES - LDSCTL_OFF) / 4; u += NWAVES * 64) ((LAS unsigned*)(lds + LDSCTL_OFF))[u] = 0u;
    __syncthreads();
    XcdBarrier bar; bar.bar = (unsigned*)(args.ws + WS_CTL) + CW_BAR; bar.x = 0; bar.st = nullptr;
    if (!MK_PER_PHASE) bar = xcd_barrier_post((unsigned*)(args.ws + WS_CTL) + CW_BAR, (volatile LAS unsigned*)(lds + MISC_OFF) + 8);
    const int lo = args.ph_lo, hi = args.ph_hi;
#ifdef PROF_MASK
    unsigned long long prof_acc = 0ull, prof_t0 = __builtin_amdgcn_s_memrealtime();
#define PROF_MARK(kind_) do { const unsigned long long t_ = __builtin_amdgcn_s_memrealtime(); if ((PROF_MASK >> (kind_)) & 1) prof_acc += t_ - prof_t0; prof_t0 = t_; } while (0)
#else
#define PROF_MARK(kind_) do {} while (0)
#endif
    if (lo == 0) {
        const ArgsP A = get_args(); unsigned char* ws = A->ws;
        int G = gridDim.x, bx = blockIdx.x; asm volatile("" : "+s"(G), "+s"(bx));
        wlist_run<false>(A, lds, bx, G);
        if (bx < 32) { const Ids I = make_ids(); p0_rows(A, MPAD, MPAD + 512, bx * NWAVES + I.wave, 32 * NWAVES); }
        unsigned* c256 = (unsigned*)(ws + WS_CTL) + CW_FIN + 64 * 72;
        asm volatile("s_waitcnt vmcnt(0)" ::: "memory"); __syncthreads();
        if (threadIdx.x == 0) { __builtin_amdgcn_fence(__ATOMIC_RELEASE, "agent"); asm volatile("s_waitcnt vmcnt(0)" ::: "memory"); __hip_atomic_fetch_add(c256, 1u, __ATOMIC_RELAXED, __HIP_MEMORY_SCOPE_AGENT); }
        if (bx < 32) {
            if (threadIdx.x < 64) { unsigned spins = 0;
                while ((unsigned)__builtin_amdgcn_readfirstlane(__hip_atomic_load(c256, __ATOMIC_RELAXED, __HIP_MEMORY_SCOPE_AGENT)) < (unsigned)G && ++spins < (1u << 22)) __builtin_amdgcn_s_sleep(2);
                __builtin_amdgcn_fence(__ATOMIC_ACQUIRE, "agent"); asm volatile("s_waitcnt vmcnt(0)" ::: "memory"); }
            __syncthreads();
            pg8::Gemm g{(const bf16*)(ws + WS_MEMB), (const bf16*)(ws + WS_WMEM), 512, DEPTH * DM, DM}; pg8::StaticOrder S; S.init(512, DEPTH * DM, G, bx);
            pg8::EpiMem E{A->out + O_MK, A->out + O_MV, (bf16*)(ws + WS_MKB), (bf16*)(ws + WS_MVB), (const float*)(ws + WS_RSQM)};
            pg8::gemm_phase<pg8::EpiMem, pg8::StaticOrder, true, true>(lds + RING_OFF, g, S, E); PROF_MARK(19);
        } else {
            wlist_run<true>(A, lds, bx - 32, G - 32); PROF_MARK(20);
            int tid = threadIdx.x; asm volatile("" : "+v"(tid)); const int wv = __builtin_amdgcn_readfirstlane(tid >> 6);
            p0_rows(A, 0, MPAD, (bx - 32) * NWAVES + wv, (G - 32) * NWAVES);
            p0_misc(A, (bx - 32) * (NWAVES * 64) + tid, (G - 32) * (NWAVES * 64));
            p0_rope(A, (bx - 32) * (NWAVES * 64) + tid, (G - 32) * (NWAVES * 64)); PROF_MARK(21);
        }
        if (!MK_PER_PHASE && 1 < hi) xcd_barrier(bar); PROF_MARK(K_P0); }
#pragma unroll 1
    for (int ph = (lo > 1 ? lo : 1); ph < hi; ++ph) {
        const ArgsP A = get_args();
        unsigned char* ws = A->ws;
        int G = gridDim.x, bx = blockIdx.x; asm volatile("" : "+s"(G), "+s"(bx));
        int kind, l; decode_phase(ph, kind, l);
        switch (kind) {
        case K_IN: {
            const int N = (l == N_A) ? DIN + 256 : DIN;
            pg8::Gemm g{(const bf16*)(ws + WS_XB), (const bf16*)(ws + WS_WIN + l * WIN_STRIDE), MP, N, DM}; pg8::StaticOrder S; S.init(MP, N, G, bx);
            pg8::EpiIn E{(bf16*)(ws + WS_PROJ), (bf16*)(ws + WS_KB), (bf16*)(ws + WS_VB), (const float*)(ws + WS_ROWSQ) + (size_t)l * MPAD, (const float*)(ws + WS_ROPE), A->out, l >= N_A ? 1 : 0};
            const int skb = (l == N_A) ? 64 : 0, nown = (l == N_A) ? G - 64 : G;
            { const Ids I = make_ids(); const int it = (l == N_A) ? bx - skb : (I.gw >> 3); if (it >= 0 && it < N / 16 && (it & 1)) skinny_in_item(A, I, l, it, lds); }
            pg8::gemm_phase<pg8::EpiIn, pg8::StaticOrder, true, true>(lds + RING_OFF, g, S, E); PROF_MARK(8);
            { const Ids I = make_ids(); const int it = (l == N_A) ? bx - skb : (I.gw >> 3); if (it >= 0 && it < N / 16 && !(it & 1)) skinny_in_item(A, I, l, it, lds);
              if (it >= 0 && it + nown < N / 16) skinny_in_item(A, I, l, it + nown, lds); } PROF_MARK(9);
        } break;
        case K_LRU1: {
            const Ids I = make_ids();
            lru_prompt_pass<1>(A, I, l, lds); PROF_MARK(12);
#pragma nounroll
            for (int s = 0; s < 2; ++s) {
                if ((s ^ (bx >> 3)) & 1) smem_two(A, I, l, I.gw >> 3, (I.gw >> 3) + 256, lds);
                else for (int u = I.gw >> 3; u < 256; u += G) mem_unit(A, I, l, u, lds);
            } PROF_MARK(13);
            lru_prompt_pass2(A, I, l, lds); PROF_MARK(15);
            for (int u = I.gw >> 3; u < 64; u += G) lru_sample_item(A, I, l, u, lds); PROF_MARK(16);
        } break;
        case K_ATT: {
            const Ids I = make_ids();
#pragma nounroll
            for (int s = 0; s < 3; ++s) {
                int op = s + ((bx >> 3) & 1); op = op >= 3 ? op - 3 : op;
                if (op == 0) smem_two(A, I, l, I.gw >> 3, (I.gw >> 3) + 256, lds);
                else if (op == 1) for (int u = I.gw >> 3; u < 256; u += G) swa_unit(A, I, l, u, lds);
                else for (int u = I.gw >> 3; u < 256; u += G) mem_unit(A, I, l, u, lds);
            } PROF_MARK(13);
            for (int t = I.gw; t < MS * NHEADS; t += I.NGW) sswa_task(A, l, t, I.lane); PROF_MARK(18);
        } break;
        case K_OUT: {
            pg8::Gemm g{(const bf16*)(ws + WS_Z), (const bf16*)(ws + WS_WOUT + l * WOUT_STRIDE), MP, DM, DCAT}; pg8::StaticOrder S; S.init(MP, DM, G, bx);
            if (l < DEPTH - 1) {
                pg8::EpiOut E{nullptr, (bf16*)(ws + WS_XB), (float*)(ws + WS_ROWSQ) + (size_t)(l + 1) * MPAD};
                { const Ids I = make_ids(); const int it = I.gw >> 3; if (it < DM / 16 && (it & 1)) skinny_out_item(A, I, l, it, lds); }
                pg8::gemm_phase<pg8::EpiOut, pg8::StaticOrder, true, true>(lds + RING_OFF, g, S, E); PROF_MARK(10);
                { const Ids I = make_ids(); const int it = I.gw >> 3; if (it < DM / 16 && !(it & 1)) skinny_out_item(A, I, l, it, lds); } PROF_MARK(11);
            } else {
                unsigned* fcnt = (unsigned*)(ws + WS_CTL) + CW_FIN;
                const Ids I = make_ids(); const int vcu = I.gw >> 3;
                if (vcu < DM / 16) { skinny_out_item(A, I, l, vcu, lds);
                    asm volatile("s_waitcnt vmcnt(0)" ::: "memory"); __syncthreads();
                    if (I.tid == 0) { __builtin_amdgcn_fence(__ATOMIC_RELEASE, "agent"); asm volatile("s_waitcnt vmcnt(0)" ::: "memory"); __hip_atomic_fetch_add(fcnt + 64 * 64, 1u, __ATOMIC_RELAXED, __HIP_MEMORY_SCOPE_AGENT); } }
                pg8::EpiOutFinal E{A->out + O_YP, (const bf16*)(ws + WS_XB), A->in[I_FINALG], (float*)(ws + WS_XCHG), fcnt};
                pg8::gemm_phase<pg8::EpiOutFinal, pg8::StaticOrder, false, true>(lds + RING_OFF, g, S, E); PROF_MARK(10);
                if (vcu >= 64 && vcu < 80) {
                    if (I.wave == 0) { unsigned spins = 0;
                        while ((unsigned)__builtin_amdgcn_readfirstlane(__hip_atomic_load(fcnt + 64 * 64, __ATOMIC_RELAXED, __HIP_MEMORY_SCOPE_AGENT)) < (unsigned)(DM / 16) && ++spins < (1u << 22)) __builtin_amdgcn_s_sleep(2);
                        __builtin_amdgcn_fence(__ATOMIC_ACQUIRE, "agent"); asm volatile("s_waitcnt vmcnt(0)" ::: "memory"); }
                    __syncthreads();
                    final_norm_row(A, MP + 8 * (vcu - 64) + I.wave, I.lane);
                } PROF_MARK(11);
            }
        } break;
        default: break;
        }
        if (!MK_PER_PHASE && ph + 1 < hi) xcd_barrier(bar);
        PROF_MARK(kind);
    }
#ifdef PROF_MASK
    __syncthreads();
    if (blockIdx.x == 0 && threadIdx.x == 0) { const unsigned long long t0_ = __builtin_amdgcn_s_memrealtime(); while (__builtin_amdgcn_s_memrealtime() - t0_ < 8ull * prof_acc) __builtin_amdgcn_s_sleep(8); }
#endif
}

extern "C" void kernel_launch(void* const* d_in, const int* in_sizes, int n_in, void* d_out, int out_size, void* d_ws, size_t ws_size, hipStream_t stream) {
    static int grid = 0;
    if (grid == 0) {
        if (n_in != N_IN || (size_t)out_size != O_END || ws_size < WS_END) { fprintf(stderr, "kernel_launch: unexpected shapes (n_in %d out %d ws %zu); nothing launched\n", n_in, out_size, ws_size); grid = -1; return; }
        int dev = 0, cus = 0, per_cu = 0;
        if (hipGetDevice(&dev) != hipSuccess || hipDeviceGetAttribute(&cus, hipDeviceAttributeMultiprocessorCount, dev) != hipSuccess) { grid = -1; return; }
        if (hipFuncSetAttribute((const void*)mk_fwd, hipFuncAttributeMaxDynamicSharedMemorySize, LDS_BYTES) != hipSuccess) { fprintf(stderr, "kernel_launch: hipFuncSetAttribute failed\n"); grid = -1; return; }
        if (hipOccupancyMaxActiveBlocksPerMultiprocessor(&per_cu, (const void*)mk_fwd, NWAVES * 64, LDS_BYTES) != hipSuccess || per_cu < 1) { fprintf(stderr, "kernel_launch: occupancy query reports %d\n", per_cu); }
        (void)hipGetLastError();
        if (cus != 256) { fprintf(stderr, "kernel_launch: built for a 256-CU device (got %d)\n", cus); grid = -1; return; }
        grid = cus;
    }
    if (grid < 0) return;
    if (hipMemsetAsync((char*)d_ws + WS_CTL, 0, CTL_ZERO_BYTES, stream) != hipSuccess) return;
    Args a{};
    for (int i = 0; i < N_IN; ++i) a.in[i] = (const float*)d_in[i];
    a.out = (float*)d_out; a.ws = (unsigned char*)d_ws;
#if MK_PER_PHASE
    for (int p = 0; p < NPHASES; ++p) { a.ph_lo = p; a.ph_hi = p + 1; hipLaunchKernelGGL(mk_fwd, dim3(grid), dim3(NWAVES * 64), LDS_BYTES, stream, a); }
#else
    a.ph_lo = 0; a.ph_hi = NPHASES; hipLaunchKernelGGL(mk_fwd, dim3(grid), dim3(NWAVES * 64), LDS_BYTES, stream, a);
#endif
}
```
